# Optimizing an MI355X kernel written in HIP

```python
import math
import jax, jax.numpy as jnp
from jax import lax
import numpy as np

D_MODEL = 1024
BATCH = 8
SEQ = 4096
DEPTH = 2

N_BRANCH = 4
BRANCH_W = 512
A_GROUPS = 4
A_CHUNK = 128
A_GROUP_W = BRANCH_W // A_GROUPS
B_HEADS = 4
B_HEAD_DIM = BRANCH_W // B_HEADS
MOBA_BLOCK = 256
MOBA_TOP_K = 3
MOBA_QUERY_CHUNK = 32
C_HEADS = 4
C_KEY_W = BRANCH_W // 2
C_HEAD_K = C_KEY_W // C_HEADS
C_HEAD_V = BRANCH_W // C_HEADS
GLA_RANK = 16
GLA_TAU = 16.0
GLA_CHUNK = 64
CONV_W = 3
EPS = 1e-6

A_COLS = 3 * BRANCH_W
B_COLS = 4 * BRANCH_W
C_COLS = 2 * C_KEY_W + 2 * BRANCH_W + GLA_RANK
D_COLS = 4 * BRANCH_W
A_OFF = 0
B_OFF = A_OFF + A_COLS
C_OFF = B_OFF + B_COLS
D_OFF = C_OFF + C_COLS
N_IN_COLS = D_OFF + D_COLS

kernel_name = "hybrid_gated_parallel_mixers"


def rms_norm(x, g):
    xf = x.astype(jnp.float32)
    y = xf * lax.rsqrt(jnp.mean(xf * xf, axis=-1, keepdims=True) + EPS)
    return (y * g.astype(jnp.float32)).astype(x.dtype)


def layer_norm(x, g, b):
    xf = x.astype(jnp.float32)
    mu = jnp.mean(xf, axis=-1, keepdims=True)
    var = jnp.mean(jnp.square(xf - mu), axis=-1, keepdims=True)
    y = (xf - mu) * lax.rsqrt(var + EPS)
    return (y * g.astype(jnp.float32) + b.astype(jnp.float32)).astype(x.dtype)


def alibi_slopes(n_heads):
    return jnp.exp2(-8.0 * jnp.arange(1, n_heads + 1, dtype=jnp.float32) / n_heads)


def spatial_gating_branch(p, ln_g, ln_b, ws, bs):
    bsz, s, _ = p.shape
    u, v, z = jnp.split(p, 3, axis=-1)
    u = jax.nn.gelu(u)
    v = layer_norm(jax.nn.gelu(v), ln_g, ln_b)
    nc = s // A_CHUNK
    v = v.reshape(bsz, nc, A_CHUNK, A_GROUPS, A_GROUP_W)
    causal = jnp.tril(jnp.ones((A_CHUNK, A_CHUNK), dtype=bool))
    w = jnp.where(causal[None], ws, jnp.zeros_like(ws))
    mixed = jnp.einsum('gts,bcsgd->bctgd', w, v) + bs.T[:, :, None]
    mixed = mixed.reshape(bsz, s, BRANCH_W)
    return u * mixed * jax.nn.silu(z)


def moba_branch(p, qn_g, kn_g):
    bsz, s, _ = p.shape
    hd = B_HEAD_DIM
    q, k, v, z = jnp.split(p, 4, axis=-1)
    q = rms_norm(q.reshape(bsz, s, B_HEADS, hd), qn_g)
    k = rms_norm(k.reshape(bsz, s, B_HEADS, hd), kn_g)
    v = v.reshape(bsz, s, B_HEADS, hd)
    nblk = -(-s // MOBA_BLOCK)
    s_pad = nblk * MOBA_BLOCK
    pad = ((0, 0), (0, s_pad - s), (0, 0), (0, 0))
    q, k, v = [jnp.pad(t, pad).transpose(0, 2, 1, 3) for t in (q, k, v)]
    kb = k.reshape(bsz, B_HEADS, nblk, MOBA_BLOCK, hd)
    vb = v.reshape(bsz, B_HEADS, nblk, MOBA_BLOCK, hd)
    k_mean = jnp.mean(kb.astype(jnp.float32), axis=3)

    pos = jnp.arange(s_pad)
    q_blk = pos // MOBA_BLOCK
    gate = jnp.einsum('bhtd,bhnd->bhtn', q.astype(jnp.float32), k_mean)
    fully_past = jnp.arange(nblk)[None, :] < q_blk[:, None]
    gate = jnp.where(fully_past, gate, -jnp.inf)
    n_sel = min(MOBA_TOP_K, nblk)
    _, sel = lax.top_k(gate, n_sel)
    sel_valid = sel < q_blk[:, None]

    scale = hd ** -0.5
    slopes = alibi_slopes(B_HEADS)
    qc_len = MOBA_QUERY_CHUNK
    bi = jnp.arange(bsz)[:, None, None, None]
    hi = jnp.arange(B_HEADS)[None, :, None, None]

    def attend_chunk(c):
        t0 = c * qc_len
        qc = lax.dynamic_slice_in_dim(q, t0, qc_len, axis=2)
        sel_c = lax.dynamic_slice_in_dim(sel, t0, qc_len, axis=2)
        valid_c = lax.dynamic_slice_in_dim(sel_valid, t0, qc_len, axis=2)
        t_pos = t0 + jnp.arange(qc_len)
        blk = t0 // MOBA_BLOCK
        k_sel = kb[bi, hi, sel_c]
        v_sel = vb[bi, hi, sel_c]
        k_pos_sel = sel_c[..., None] * MOBA_BLOCK + jnp.arange(MOBA_BLOCK)
        s_sel = jnp.einsum('bhqd,bhqnkd->bhqnk', qc, k_sel,
                           preferred_element_type=jnp.float32) * scale
        s_sel = s_sel - slopes[:, None, None, None] * (t_pos[:, None, None] - k_pos_sel)
        s_sel = jnp.where(valid_c[..., None], s_sel, -jnp.inf)
        k_own = lax.dynamic_index_in_dim(kb, blk, axis=2, keepdims=False)
        v_own = lax.dynamic_index_in_dim(vb, blk, axis=2, keepdims=False)
        k_pos_own = blk * MOBA_BLOCK + jnp.arange(MOBA_BLOCK)
        dist_own = t_pos[:, None] - k_pos_own[None, :]
        s_own = jnp.einsum('bhqd,bhkd->bhqk', qc, k_own,
                           preferred_element_type=jnp.float32) * scale
        s_own = s_own - slopes[:, None, None] * dist_own
        s_own = jnp.where(dist_own >= 0, s_own, -jnp.inf)
        scores = jnp.concatenate([s_sel.reshape(bsz, B_HEADS, qc_len, -1), s_own], axis=-1)
        probs = jax.nn.softmax(scores, axis=-1).astype(v.dtype)
        p_sel = probs[..., :n_sel * MOBA_BLOCK].reshape(bsz, B_HEADS, qc_len, n_sel, MOBA_BLOCK)
        p_own = probs[..., n_sel * MOBA_BLOCK:]
        return (jnp.einsum('bhqnk,bhqnkd->bhqd', p_sel, v_sel)
                + jnp.einsum('bhqk,bhkd->bhqd', p_own, v_own))

    out = lax.map(attend_chunk, jnp.arange(s_pad // qc_len))
    out = out.transpose(1, 0, 3, 2, 4).reshape(bsz, s_pad, BRANCH_W)[:, :s]
    return out * jax.nn.silu(z)


def gla_branch(p, w2, b2, on_g):
    bsz, s, _ = p.shape
    splits = [C_KEY_W, 2 * C_KEY_W, 2 * C_KEY_W + BRANCH_W, 2 * C_KEY_W + BRANCH_W + GLA_RANK]
    q, k, v, lr, z = jnp.split(p, splits, axis=-1)
    log_a = jax.nn.log_sigmoid((lr @ w2 + b2).astype(jnp.float32)) / GLA_TAU
    nc = s // GLA_CHUNK

    def to_chunks(t, dh):
        return t.astype(jnp.float32).reshape(bsz, nc, GLA_CHUNK, C_HEADS, dh).transpose(1, 0, 3, 2, 4)

    qc = to_chunks(q, C_HEAD_K) * (C_HEAD_K ** -0.5)
    kc = to_chunks(k, C_HEAD_K)
    vc = to_chunks(v, C_HEAD_V)
    gc = to_chunks(log_a, C_HEAD_K)
    causal = jnp.tril(jnp.ones((GLA_CHUNK, GLA_CHUNK), dtype=bool))

    def step(state, inp):
        qi, ki, vi, gi = inp
        b = jnp.cumsum(gi, axis=2)
        o_inter = jnp.einsum('bhtd,bhdv->bhtv', qi * jnp.exp(b), state)
        rel = b[:, :, :, None, :] - b[:, :, None, :, :]
        decay = jnp.exp(jnp.where(causal[:, :, None], rel, -jnp.inf))
        attn = jnp.einsum('bhtd,bhsd,bhtsd->bhts', qi, ki, decay)
        o_intra = jnp.einsum('bhts,bhsv->bhtv', attn, vi)
        b_last = b[:, :, -1:, :]
        k_dec = ki * jnp.exp(b_last - b)
        state = (state * jnp.exp(b_last[:, :, 0, :])[..., None]
                 + jnp.einsum('bhsd,bhsv->bhdv', k_dec, vi))
        return state, o_inter + o_intra

    state0 = jnp.zeros((bsz, C_HEADS, C_HEAD_K, C_HEAD_V), jnp.float32)
    _, o = lax.scan(step, state0, (qc, kc, vc, gc))
    o = o.transpose(1, 0, 3, 2, 4).reshape(bsz, s, C_HEADS, C_HEAD_V)
    o = rms_norm(o, on_g).reshape(bsz, s, BRANCH_W).astype(p.dtype)
    return o * jax.nn.silu(z)


def short_conv_branch(p, conv_w, conv_b):
    bg, cg, xin, z = jnp.split(p, 4, axis=-1)
    u = cg * xin
    y = lax.conv_general_dilated(u, conv_w[:, None, :].astype(u.dtype), window_strides=(1,),
                                 padding=[(CONV_W - 1, 0)],
                                 dimension_numbers=('NWC', 'WIO', 'NWC'),
                                 feature_group_count=BRANCH_W) + conv_b
    return bg * y * jax.nn.silu(z)


def setup_inputs(seed: int = 0) -> dict:
    key = jax.random.key(seed)
    ks = jax.random.split(key, 20)

    def nrm(k, shape, scale):
        return jax.random.normal(k, shape, jnp.float32) * scale

    L = DEPTH
    return {
        "x": nrm(ks[0], (BATCH, SEQ, D_MODEL), 1.0),
        "norm_g": 1.0 + nrm(ks[1], (L, D_MODEL), 0.02),
        "w_in": nrm(ks[2], (L, D_MODEL, N_IN_COLS), D_MODEL ** -0.5),
        "a_ln_g": 1.0 + nrm(ks[3], (L, BRANCH_W), 0.02),
        "a_ln_b": nrm(ks[4], (L, BRANCH_W), 0.02),
        "a_spatial_w": nrm(ks[5], (L, A_GROUPS, A_CHUNK, A_CHUNK), A_CHUNK ** -0.5),
        "a_spatial_b": 1.0 + nrm(ks[6], (L, A_GROUPS, A_CHUNK), 0.02),
        "b_q_norm_g": 1.0 + nrm(ks[7], (L, B_HEAD_DIM), 0.02),
        "b_k_norm_g": 1.0 + nrm(ks[8], (L, B_HEAD_DIM), 0.02),
        "c_gate_w2": nrm(ks[9], (L, GLA_RANK, C_KEY_W), GLA_RANK ** -0.5),
        "c_gate_b": nrm(ks[10], (L, C_KEY_W), 0.1),
        "c_out_norm_g": 1.0 + nrm(ks[11], (L, C_HEAD_V), 0.02),
        "d_conv_w": nrm(ks[12], (L, CONV_W, BRANCH_W), CONV_W ** -0.5),
        "d_conv_b": nrm(ks[13], (L, BRANCH_W), 0.02),
        "w_branch_out": nrm(ks[14], (L, N_BRANCH, BRANCH_W, D_MODEL), BRANCH_W ** -0.5),
        "w_merge_gate": nrm(ks[15], (L, N_BRANCH, D_MODEL, D_MODEL), D_MODEL ** -0.5),
        "b_merge_gate": nrm(ks[16], (L, N_BRANCH, D_MODEL), 0.02),
        "w_out": nrm(ks[17], (L, D_MODEL, D_MODEL), D_MODEL ** -0.5),
    }


def reference(x, norm_g, w_in, a_ln_g, a_ln_b, a_spatial_w, a_spatial_b,
              b_q_norm_g, b_k_norm_g, c_gate_w2, c_gate_b, c_out_norm_g,
              d_conv_w, d_conv_b, w_branch_out, w_merge_gate, b_merge_gate, w_out):
    for l in range(DEPTH):
        h = rms_norm(x, norm_g[l])
        wi = w_in[l]
        y_a = spatial_gating_branch(h @ wi[:, A_OFF:B_OFF], a_ln_g[l], a_ln_b[l],
                                    a_spatial_w[l], a_spatial_b[l])
        y_b = moba_branch(h @ wi[:, B_OFF:C_OFF], b_q_norm_g[l], b_k_norm_g[l])
        y_c = gla_branch(h @ wi[:, C_OFF:D_OFF], c_gate_w2[l], c_gate_b[l], c_out_norm_g[l])
        y_d = short_conv_branch(h @ wi[:, D_OFF:N_IN_COLS], d_conv_w[l], d_conv_b[l])
        branches = (y_a, y_b, y_c, y_d)
        merged = jnp.zeros_like(x)
        for i in range(N_BRANCH):
            gate = jax.nn.sigmoid(h @ w_merge_gate[l, i] + b_merge_gate[l, i])
            merged = merged + gate * (branches[i] @ w_branch_out[l, i])
        x = x + merged @ w_out[l]
    return x
```

```cpp
#include <hip/hip_runtime.h>
#include <hip/hip_cooperative_groups.h>
#include <cstdio>
#include <cstdint>
namespace cg = cooperative_groups;

#ifndef MK_N_LAUNCHES
#define MK_N_LAUNCHES 1
#endif

#ifndef PROBE_REP
#define PROBE_REP -1
#endif
#ifndef MERGE_S0
#define MERGE_S0 1
#endif
#define LAS __attribute__((address_space(3)))
typedef unsigned short bf16_t;
typedef short bf16x8 __attribute__((ext_vector_type(8)));
typedef float f32x4 __attribute__((ext_vector_type(4)));
typedef float f32x2 __attribute__((ext_vector_type(2)));
typedef unsigned u32x4 __attribute__((ext_vector_type(4)));
typedef unsigned u32x2 __attribute__((ext_vector_type(2)));

constexpr int DM = 1024, BATCH = 8, SEQ = 4096, DEPTH = 2, BW = 512, NIN = 7184;
constexpr int NSPLIT = 2, BPH = BATCH / NSPLIT, MH = BPH * SEQ;
constexpr int NCAT = 11264, NT1 = NCAT / 256;
constexpr int A_OFF = 0, B_OFF = 1536, C_OFF = 3584, D_OFF = 5136;
constexpr float EPS = 1e-6f;
constexpr int NWAVES = 8, NTHREADS = 512;
constexpr int LDS_BYTES = 147456 + 64;

constexpr size_t MiB = 1u << 20;
constexpr size_t W_LAYER_BYTES = 30 * MiB;
constexpr size_t WOFF_CAT = 0, WOFF_BO = (size_t)NCAT * 1024 * 2, WOFF_OUT = WOFF_BO + (size_t)4096 * 512 * 2;
static_assert(WOFF_OUT + (size_t)1024 * 1024 * 2 <= W_LAYER_BYTES, "weights");
constexpr size_t OFF_W = 0;
constexpr size_t OFF_H = 60 * MiB;
constexpr size_t OFF_YA = OFF_H, OFF_YD = OFF_H + 16 * MiB, OFF_MERGED = 188 * MiB;
constexpr size_t OFF_UZ = 92 * MiB;
constexpr size_t OFF_AV = 108 * MiB;
constexpr size_t OFF_PB = 124 * MiB;
constexpr size_t OFF_CQK = 188 * MiB;
constexpr size_t OFF_CV = 204 * MiB;
constexpr size_t OFF_CZ = 220 * MiB;
constexpr size_t OFF_DCX = 244 * MiB;
constexpr size_t OFF_DBZ = 260 * MiB;
constexpr size_t OFF_YB = 276 * MiB;
constexpr size_t OFF_G = 292 * MiB;
constexpr size_t OFF_KMEAN = 436 * MiB;
constexpr size_t OFF_WA = 436 * MiB + 512 * 1024;
constexpr size_t OFF_OL = 440 * MiB;
constexpr size_t OFF_QTO = 456 * MiB;
constexpr size_t OFF_TT = 464 * MiB;
constexpr size_t OFF_BLO = 472 * MiB;
constexpr size_t OFF_LRF = 473 * MiB;
constexpr size_t OFF_WLR = 436 * MiB + 768 * 1024;
constexpr size_t OFF_DGO = 472 * MiB + 512 * 1024;
constexpr size_t OFF_ATTP = 474 * MiB;
constexpr size_t OFF_CTL = 500 * MiB;
constexpr size_t CTL_BYTES = 65536;
constexpr size_t OFF_AMAX = OFF_CTL + 32768;
constexpr size_t OFF_RS = OFF_CTL + 65536;
constexpr size_t OFF_H8 = 276 * MiB;
constexpr size_t WOFF_G8 = (size_t)7168 * 1024 * 2;
constexpr size_t WS_END = 501 * MiB;

__device__ __forceinline__ unsigned f2bf(float f) { unsigned u = __builtin_bit_cast(unsigned, f); return (u + 0x7fffu + ((u >> 16) & 1u)) >> 16; }
typedef __bf16 bf16x2_hw __attribute__((ext_vector_type(2)));
__device__ __forceinline__ unsigned pk2(float lo, float hi) { f32x2 v = {lo, hi}; bf16x2_hw b = __builtin_convertvector(v, bf16x2_hw); return __builtin_bit_cast(unsigned, b); }
__device__ __forceinline__ float bf_lo(unsigned w) { return __builtin_bit_cast(float, w << 16); }
__device__ __forceinline__ float bf_hi(unsigned w) { return __builtin_bit_cast(float, w & 0xffff0000u); }
__device__ __forceinline__ float bf2f(bf16_t b) { return __builtin_bit_cast(float, (unsigned)b << 16); }
__device__ __forceinline__ void unpack8(const u32x4 w, float (&f)[8]) { f[0] = bf_lo(w.x); f[1] = bf_hi(w.x); f[2] = bf_lo(w.y); f[3] = bf_hi(w.y); f[4] = bf_lo(w.z); f[5] = bf_hi(w.z); f[6] = bf_lo(w.w); f[7] = bf_hi(w.w); }
__device__ __forceinline__ u32x4 pack8(const float (&f)[8]) { u32x4 w; w.x = pk2(f[0], f[1]); w.y = pk2(f[2], f[3]); w.z = pk2(f[4], f[5]); w.w = pk2(f[6], f[7]); return w; }
__device__ __forceinline__ int opaque_lane() { int l; asm volatile("v_mbcnt_lo_u32_b32 %0, -1, 0\n\tv_mbcnt_hi_u32_b32 %0, -1, %0" : "=v"(l)); return l; }
__device__ __forceinline__ int opaque_s(int v) { asm volatile("" : "+s"(v)); return v; }
template <int CTRL> __device__ __forceinline__ float dpp_t(float v) { return __builtin_bit_cast(float, __builtin_amdgcn_update_dpp(0, __builtin_bit_cast(int, v), CTRL, 0xf, 0xf, true)); }
#define dpp_f(v, ctrl) dpp_t<ctrl>(v)
#define DPP_QX1 0xB1
#define DPP_QX2 0x4E
#define DPP_HMIR 0x141
#define DPP_RMIR 0x140
#define DPP_ROR8 0x128
__device__ __forceinline__ float swz_x4(float v) { return __builtin_bit_cast(float, __builtin_amdgcn_ds_swizzle(__builtin_bit_cast(int, v), (4 << 10) | 0x1f)); }
__device__ __forceinline__ float sum_x16(float v) { auto r = __builtin_amdgcn_permlane16_swap(__float_as_uint(v), __float_as_uint(v), false, false); return __uint_as_float(r[0]) + __uint_as_float(r[1]); }
__device__ __forceinline__ float sum_x32(float v) { auto r = __builtin_amdgcn_permlane32_swap(__float_as_uint(v), __float_as_uint(v), false, false); return __uint_as_float(r[0]) + __uint_as_float(r[1]); }
__device__ __forceinline__ float xchg16(float v, bool odd_row) { auto r = __builtin_amdgcn_permlane16_swap(__float_as_uint(v), __float_as_uint(v), false, false); return __uint_as_float(odd_row ? r[0] : r[1]); }
__device__ __forceinline__ float xchg32(float v, bool upper) { auto r = __builtin_amdgcn_permlane32_swap(__float_as_uint(v), __float_as_uint(v), false, false); return __uint_as_float(upper ? r[0] : r[1]); }
__device__ __forceinline__ float row16_sum(float v) { v += dpp_f(v, DPP_QX1); v += dpp_f(v, DPP_QX2); v += dpp_f(v, DPP_HMIR); v += dpp_f(v, DPP_RMIR); return v; }
__device__ __forceinline__ float wave_sum(float v) { return sum_x32(sum_x16(row16_sum(v))); }
__device__ __forceinline__ float wave_max(float v) { v = fmaxf(v, dpp_f(v, DPP_QX1)); v = fmaxf(v, dpp_f(v, DPP_QX2)); v = fmaxf(v, dpp_f(v, DPP_HMIR)); v = fmaxf(v, dpp_f(v, DPP_RMIR));
    { auto r = __builtin_amdgcn_permlane16_swap(__float_as_uint(v), __float_as_uint(v), false, false); v = fmaxf(__uint_as_float(r[0]), __uint_as_float(r[1])); }
    { auto r = __builtin_amdgcn_permlane32_swap(__float_as_uint(v), __float_as_uint(v), false, false); v = fmaxf(__uint_as_float(r[0]), __uint_as_float(r[1])); } return v; }
__device__ __forceinline__ unsigned pk4_fp8(float a, float b, float c, float d) { int w = __builtin_amdgcn_cvt_pk_fp8_f32(a, b, 0, false); w = __builtin_amdgcn_cvt_pk_fp8_f32(c, d, w, true); return (unsigned)w; }
__device__ __forceinline__ f32x2 exp2_2(f32x2 t) { f32x2 e; e.x = __builtin_amdgcn_exp2f(t.x); e.y = __builtin_amdgcn_exp2f(t.y); return e; }
__device__ __forceinline__ f32x2 rcp_2(f32x2 d) { f32x2 r; r.x = __builtin_amdgcn_rcpf(d.x); r.y = __builtin_amdgcn_rcpf(d.y); return r; }
enum { ACT_NONE = 0, ACT_GELU = 1, ACT_SILU = 2, ACT_SIGM = 3 };
template <int ACT> __device__ __forceinline__ f32x2 den2(f32x2 x) {
    if (ACT == ACT_NONE) return (f32x2){1.f, 1.f};
    if (ACT == ACT_GELU) { const f32x2 x2 = x * x; const f32x2 a = x * (x2 * (-0.044715f * 1.5957691216057308f * 1.4426950408889634f) + (-1.5957691216057308f * 1.4426950408889634f)); return exp2_2(a) + 1.0f; }
    return exp2_2(x * (-1.4426950408889634f)) + 1.0f;
}
template <int ACT> __device__ __forceinline__ f32x2 num2(f32x2 x) { if (ACT == ACT_SIGM) return (f32x2){1.f, 1.f}; return x; }
template <int ACT> __device__ __forceinline__ f32x2 act2(f32x2 x) { if (ACT == ACT_NONE) return x; return num2<ACT>(x) * rcp_2(den2<ACT>(x)); }
template <int A0, int A1> __device__ __forceinline__ f32x2 act2_prod(f32x2 a, f32x2 b) {
    if (A0 == ACT_NONE && A1 == ACT_NONE) return a * b;
    if (A0 == ACT_NONE) return a * act2<A1>(b);
    if (A1 == ACT_NONE) return act2<A0>(a) * b;
    return (num2<A0>(a) * num2<A1>(b)) * rcp_2(den2<A0>(a) * den2<A1>(b));
}

namespace pg8 {
constexpr int BM = 256, BK = 64, HALF = 128, HTB = HALF * BK * 2, STAGE_BYTES = 8 * HTB, NXCD = 8, WGM = 4;
__device__ __forceinline__ int lds_byte(int r, int c) { const int st = (r >> 4) * 2 + (c >> 5), rr = r & 15, cc = c & 31, ob = rr * 64 + cc * 2; return st * 1024 + (ob ^ (((ob >> 9) & 1) << 5)); }
__device__ __forceinline__ void stage_rc(int b, int& R, int& C) { const int st = b / 1024, sb = b % 1024, swz = sb ^ (((sb >> 9) & 1) << 5); R = (st >> 1) * 16 + swz / 64; C = (st & 1) * 32 + (swz % 64) / 2; }
__device__ __forceinline__ int perm32(int rho) { const int n = rho >> 4, i = rho & 15; return 8 * (i >> 2) + 4 * n + (i & 3); }

struct Unit { int pm, pn; };
struct GUnit { int pm, pn, br; const char* A; const char* B; };
struct StaticOrder {
    int nM, nN, nwg, G, c;
    __device__ void init(int M, int N, int G_, int c_) { nM = M / BM; nN = N / BM; nwg = nM * nN; G = G_; c = c_; }
    __device__ bool next(int i, Unit& u) const {
        const long L = (long)i * G + c; if (L >= nwg) return false;
        int wgid = (int)L; { const int q = nwg / NXCD, r = nwg % NXCD, xcd = wgid % NXCD, off = wgid / NXCD; wgid = (xcd < r ? xcd * (q + 1) : r * (q + 1) + (xcd - r) * q) + off; }
        const int nig = WGM * nN, gid = wgid / nig, fm = gid * WGM, gsz = (nM - fm) < WGM ? (nM - fm) : WGM;
        u.pm = fm + ((wgid % nig) % gsz); u.pn = (wgid % nig) / gsz; return true;
    }
};

typedef int i32x4v __attribute__((ext_vector_type(4)));
typedef int i32x8v __attribute__((ext_vector_type(8)));
__device__ __forceinline__ i32x8v cat8(bf16x8 a, bf16x8 b) { return __builtin_shufflevector(__builtin_bit_cast(i32x4v, a), __builtin_bit_cast(i32x4v, b), 0, 1, 2, 3, 4, 5, 6, 7); }
template <class Epi, class Sched, bool ALIGN_EPI, bool FP8 = false>
__device__ __forceinline__ void gemm_phase(LAS unsigned char* lds, const int tid, const int K, const int lda, const int ldb, const Sched& S, const Epi& E) {
    const int wid = __builtin_amdgcn_readfirstlane(tid >> 6), lane = tid & 63, wr = wid >> 2, wc = wid & 3, fr = lane & 15, fq = lane >> 4;
    const int nt = K / BK;
    unsigned voffA[2], voffB[2];
#pragma unroll
    for (int i = 0; i < 2; ++i) { int R, C; stage_rc(tid * 16 + i * 8192, R, C); const int Rb = Epi::PERM ? ((R & ~31) + perm32(R & 31)) : R;
        voffA[i] = (unsigned)(R * lda + C) * 2u; voffB[i] = (unsigned)(Rb * ldb + C) * 2u; }
    const size_t kstep = (size_t)(BK * 2);
    const size_t hA = (size_t)HALF * lda * 2, hB = (size_t)HALF * ldb * 2;
    const unsigned ldsw = (unsigned)wid * 1024u;
    const int aoff = lds_byte(wr * 64 + fr, fq * 8), boff = lds_byte(wc * 32 + fr, fq * 8);
#define PG8_SA(b, h) (((b) * 2 + (h)) * HTB)
#define PG8_SB(b, h) ((4 + (b) * 2 + (h)) * HTB)
#define PG8_STAGE(bufoff, gbase, voff) do { _Pragma("unroll") for (int _i = 0; _i < 2; ++_i) { unsigned vo_ = (voff)[_i]; asm volatile("" : "+v"(vo_));   \
        __builtin_amdgcn_global_load_lds((const unsigned*)((const char*)(gbase) + vo_), (LAS unsigned*)(lds + (bufoff) + ldsw + _i * 8192), 16, 0, 0); } } while (0)
#define PG8_LDA(dst, b, h) do { _Pragma("unroll") for (int m = 0; m < 4; ++m) { const bf16x8 x0_ = *(const LAS bf16x8*)(lds + PG8_SA(b, h) + aoff + m * 2048), x1_ = *(const LAS bf16x8*)(lds + PG8_SA(b, h) + aoff + m * 2048 + 1024); \
        if constexpr (FP8) dst##8[m] = cat8(x0_, x1_); else { dst[m][0] = x0_; dst[m][1] = x1_; } } } while (0)
#define PG8_LDB(dst, b, h) do { _Pragma("unroll") for (int n = 0; n < 2; ++n) { const bf16x8 x0_ = *(const LAS bf16x8*)(lds + PG8_SB(b, h) + boff + n * 2048), x1_ = *(const LAS bf16x8*)(lds + PG8_SB(b, h) + boff + n * 2048 + 1024); \
        if constexpr (FP8) dst##8[n] = cat8(x0_, x1_); else { dst[n][0] = x0_; dst[n][1] = x1_; } } } while (0)
#define PG8_MMA(ai, bj, At, Bt) do { __builtin_amdgcn_s_setprio(1); _Pragma("unroll") for (int m = 0; m < 4; ++m) _Pragma("unroll") for (int n = 0; n < 2; ++n) { \
        if constexpr (FP8) acc[ai][bj][m][n] = __builtin_amdgcn_mfma_scale_f32_16x16x128_f8f6f4(Bt##8[n], At##8[m], acc[ai][bj][m][n], 0, 0, 0, 0, 0, 0); \
        else { _Pragma("unroll") for (int k = 0; k < 2; ++k) acc[ai][bj][m][n] = __builtin_amdgcn_mfma_f32_16x16x32_bf16(Bt[n][k], At[m][k], acc[ai][bj][m][n], 0, 0, 0); } } \
        __builtin_amdgcn_s_setprio(0); } while (0)
#define PG8_WAIT_V(n) asm volatile("s_waitcnt vmcnt(" #n ")" ::: "memory")
#define PG8_WAIT_L(n) asm volatile("s_waitcnt lgkmcnt(" #n ")" ::: "memory")
#define PG8_BAR __builtin_amdgcn_s_barrier()
#define PG8_SCHED __builtin_amdgcn_sched_barrier(0)
    GUnit cur, nxt; int ui = 0;
    if (!S.next(0, cur)) return;
    f32x4 acc[2][2][4][2];
#pragma unroll
    for (int a = 0; a < 2; ++a)
#pragma unroll
        for (int b = 0; b < 2; ++b)
#pragma unroll
            for (int m = 0; m < 4; ++m)
#pragma unroll
                for (int n = 0; n < 2; ++n) acc[a][b][m][n] = (f32x4){0.f, 0.f, 0.f, 0.f};
    bf16x8 At[4][2], B0[2][2], B1[2][2]; i32x8v At8[4], B08[2], B18[2];
    const char* cA = cur.A; const char* cB = cur.B;
    PG8_STAGE(PG8_SB(0, 0), cB, voffB); PG8_STAGE(PG8_SB(0, 1), cB + hB, voffB); PG8_STAGE(PG8_SA(0, 0), cA, voffA); PG8_STAGE(PG8_SA(0, 1), cA + hA, voffA);
    if (wr == 1) PG8_BAR;
    PG8_WAIT_V(2); PG8_BAR;
    PG8_STAGE(PG8_SB(1, 0), cB + kstep, voffB); PG8_STAGE(PG8_SA(1, 0), cA + kstep, voffA); PG8_STAGE(PG8_SB(1, 1), cB + hB + kstep, voffB);
    PG8_WAIT_V(6); PG8_BAR;
    for (;;) {
        const bool has_next = S.next(ui + 1, nxt);
        const char* nA = has_next ? nxt.A : cA; const char* nB = has_next ? nxt.B : cB;
#pragma unroll 1
        for (int t = 0; t < nt; t += 2) {
            const bool last = (t == nt - 2);
            const char* a1 = cA + (size_t)(t + 1) * kstep;
            const char* a2 = last ? nA : cA + (size_t)(t + 2) * kstep; const char* b2 = last ? nB : cB + (size_t)(t + 2) * kstep;
            const char* a3 = a2 + kstep; const char* b3 = b2 + kstep;
            PG8_LDB(B0, 0, 0); PG8_LDB(B1, 0, 1); PG8_SCHED; PG8_LDA(At, 0, 0); PG8_STAGE(PG8_SA(1, 1), a1 + hA, voffA);
            PG8_WAIT_V(8); PG8_WAIT_L(0); PG8_BAR; PG8_MMA(0, 0, At, B0); PG8_MMA(0, 1, At, B1); PG8_BAR; PG8_SCHED;
            PG8_LDA(At, 0, 1); PG8_STAGE(PG8_SB(0, 0), b2, voffB); PG8_STAGE(PG8_SB(0, 1), b2 + hB, voffB); PG8_STAGE(PG8_SA(0, 0), a2, voffA);
            PG8_WAIT_V(8); PG8_WAIT_L(0); PG8_BAR; PG8_MMA(1, 0, At, B0); PG8_MMA(1, 1, At, B1); PG8_BAR; PG8_SCHED;
            PG8_LDB(B0, 1, 0); PG8_LDB(B1, 1, 1); PG8_SCHED; PG8_LDA(At, 1, 0); PG8_STAGE(PG8_SA(0, 1), a2 + hA, voffA);
            PG8_WAIT_V(8); PG8_WAIT_L(0); PG8_BAR; PG8_MMA(0, 0, At, B0); PG8_MMA(0, 1, At, B1); PG8_BAR; PG8_SCHED;
            PG8_LDA(At, 1, 1); PG8_STAGE(PG8_SB(1, 0), b3, voffB); PG8_STAGE(PG8_SB(1, 1), b3 + hB, voffB); PG8_STAGE(PG8_SA(1, 0), a3, voffA);
            PG8_WAIT_V(8); PG8_WAIT_L(0); PG8_BAR; PG8_MMA(1, 0, At, B0); PG8_MMA(1, 1, At, B1); PG8_BAR; PG8_SCHED;
        }
        if constexpr (ALIGN_EPI) { if (wr == 0) PG8_BAR; }
        E(acc, cur, wr, wc, fr, fq);
        if (PROBE_REP == 21) E(acc, cur, wr, wc, fr, fq);
        if (!has_next) break;
#pragma unroll
        for (int a = 0; a < 2; ++a)
#pragma unroll
            for (int b = 0; b < 2; ++b)
#pragma unroll
                for (int m = 0; m < 4; ++m)
#pragma unroll
                    for (int n = 0; n < 2; ++n) acc[a][b][m][n] = (f32x4){0.f, 0.f, 0.f, 0.f};
        cur = nxt; cA = nA; cB = nB; ++ui;
        if constexpr (ALIGN_EPI) { if (wr == 1) PG8_BAR; }
    }
    PG8_WAIT_V(0);
    if constexpr (!ALIGN_EPI) { if (wr == 0) PG8_BAR; }
    PG8_BAR;
#undef PG8_SA
#undef PG8_SB
#undef PG8_STAGE
#undef PG8_LDA
#undef PG8_LDB
#undef PG8_MMA
#undef PG8_WAIT_V
#undef PG8_WAIT_L
#undef PG8_BAR
#undef PG8_SCHED
}
}

typedef const f32x4 (&AccRef)[2][2][4][2];

struct LPerm { LAS unsigned char* sc; unsigned wpos, rpos; int lr, lp; };
__device__ __forceinline__ LPerm lperm_init(LAS unsigned char* scr, int wid) {
    const int ln = opaque_lane(), fr = ln & 15, fq = ln >> 4, pw = 4 * fr + fq;
    LPerm P; P.sc = scr + wid * 2048; P.wpos = 16u * (unsigned)(pw ^ ((pw >> 3) & 3)); P.rpos = 16u * (unsigned)(ln ^ ((ln >> 3) & 3)); P.lr = ln >> 2; P.lp = ln & 3; return P;
}
__device__ __forceinline__ u32x4 lperm_rows(const LPerm& P, int slot, u32x4 w) { LAS unsigned char* s_ = P.sc + slot * 1024; *(LAS u32x4*)(s_ + P.wpos) = w; const u32x4 t_ = *(const LAS u32x4*)(s_ + P.rpos); __builtin_amdgcn_sched_barrier(0); return t_; }

template <int ACT, bool HASBIAS>
__device__ __forceinline__ void epi_plain(AccRef acc, const pg8::GUnit& u, int wr, int wc, LAS unsigned char* scr, bf16_t* base, int ldc, int col, const float* bias) {
    const LPerm P = lperm_init(scr, wr * 4 + wc);
    bf16_t* ob = base + (size_t)(u.pm * 256 + wr * 64 + P.lr) * ldc + col + wc * 32 + 8 * P.lp;
    f32x4 bv[2][2];
#pragma unroll
    for (int bj = 0; bj < 2; ++bj)
#pragma unroll
        for (int n = 0; n < 2; ++n) bv[bj][n] = HASBIAS ? *(const f32x4*)(bias + bj * 128 + wc * 32 + 8 * (opaque_lane() >> 4) + 4 * n) : (f32x4){0.f, 0.f, 0.f, 0.f};
    u32x4 pend; bf16_t* pdst = ob;
#pragma unroll
    for (int ai = 0; ai < 2; ++ai)
#pragma unroll
        for (int m = 0; m < 4; ++m) {
#pragma unroll
            for (int bj = 0; bj < 2; ++bj) { const f32x4 v0 = acc[ai][bj][m][0] + bv[bj][0], v1 = acc[ai][bj][m][1] + bv[bj][1];
                const f32x2 r0 = act2<ACT>((f32x2){v0[0], v0[1]}), r1 = act2<ACT>((f32x2){v0[2], v0[3]}), r2 = act2<ACT>((f32x2){v1[0], v1[1]}), r3 = act2<ACT>((f32x2){v1[2], v1[3]});
                u32x4 w; w.x = pk2(r0.x, r0.y); w.y = pk2(r1.x, r1.y); w.z = pk2(r2.x, r2.y); w.w = pk2(r3.x, r3.y);
                if (ai + m + bj > 0) __builtin_nontemporal_store(pend, (u32x4*)pdst);
                pend = lperm_rows(P, bj, w); pdst = ob + (size_t)(ai * 128 + m * 16) * ldc + bj * 128; } }
    __builtin_nontemporal_store(pend, (u32x4*)pdst);
}
template <int A0, int A1>
__device__ __forceinline__ void epi_pair(AccRef acc, const pg8::GUnit& u, int wr, int wc, LAS unsigned char* scr, bf16_t* base, int ldc, int col) {
    const LPerm P = lperm_init(scr, wr * 4 + wc);
    bf16_t* ob = base + (size_t)(u.pm * 256 + wr * 64 + P.lr) * ldc + col + wc * 32 + 8 * P.lp;
    u32x4 pend; bf16_t* pdst = ob;
#pragma unroll
    for (int ai = 0; ai < 2; ++ai)
#pragma unroll
        for (int m = 0; m < 4; ++m) {
            const f32x4 a0 = acc[ai][0][m][0], a1 = acc[ai][0][m][1], b0 = acc[ai][1][m][0], b1 = acc[ai][1][m][1];
            const f32x2 r0 = act2_prod<A0, A1>((f32x2){a0[0], a0[1]}, (f32x2){b0[0], b0[1]}), r1 = act2_prod<A0, A1>((f32x2){a0[2], a0[3]}, (f32x2){b0[2], b0[3]});
            const f32x2 r2 = act2_prod<A0, A1>((f32x2){a1[0], a1[1]}, (f32x2){b1[0], b1[1]}), r3 = act2_prod<A0, A1>((f32x2){a1[2], a1[3]}, (f32x2){b1[2], b1[3]});
            u32x4 w; w.x = pk2(r0.x, r0.y); w.y = pk2(r1.x, r1.y); w.z = pk2(r2.x, r2.y); w.w = pk2(r3.x, r3.y);
            if (ai + m > 0) __builtin_nontemporal_store(pend, (u32x4*)pdst);
            pend = lperm_rows(P, m & 1, w); pdst = ob + (size_t)(ai * 128 + m * 16) * ldc; }
    __builtin_nontemporal_store(pend, (u32x4*)pdst);
}
struct EpiP1 {
    static constexpr bool PERM = true;
    unsigned char* ws; LAS unsigned char* scr;
    __device__ __forceinline__ void operator()(AccRef acc, const pg8::GUnit& u, int wr, int wc, int, int) const {
        const int pn = u.pn;
        if (pn < 4) epi_pair<ACT_GELU, ACT_SILU>(acc, u, wr, wc, scr, (bf16_t*)(ws + OFF_UZ), 512, 128 * pn);
        else if (pn < 6) epi_plain<ACT_GELU, false>(acc, u, wr, wc, scr, (bf16_t*)(ws + OFF_AV), 512, 256 * (pn - 4), nullptr);
        else if (pn < 12) epi_plain<ACT_NONE, false>(acc, u, wr, wc, scr, (bf16_t*)(ws + OFF_PB), 2048, 256 * (pn - 6), nullptr);
        else if (pn < 14) epi_plain<ACT_SILU, false>(acc, u, wr, wc, scr, (bf16_t*)(ws + OFF_PB), 2048, 256 * (pn - 6), nullptr);
        else if (pn < 16) epi_plain<ACT_NONE, false>(acc, u, wr, wc, scr, (bf16_t*)(ws + OFF_CQK), 512, 256 * (pn - 14), nullptr);
        else if (pn < 18) epi_plain<ACT_NONE, false>(acc, u, wr, wc, scr, (bf16_t*)(ws + OFF_CV), 512, 256 * (pn - 16), nullptr);
        else if (pn < 20) epi_plain<ACT_SILU, false>(acc, u, wr, wc, scr, (bf16_t*)(ws + OFF_CZ), 512, 256 * (pn - 18), nullptr);
        else if (pn < 24) epi_pair<ACT_NONE, ACT_NONE>(acc, u, wr, wc, scr, (bf16_t*)(ws + OFF_DCX), 512, 128 * (pn - 20));
        else epi_pair<ACT_NONE, ACT_SILU>(acc, u, wr, wc, scr, (bf16_t*)(ws + OFF_DBZ), 512, 128 * (pn - 24));
    }
};
struct EpiG {
    static constexpr bool PERM = true;
    bf16_t* G; const float* bmg; const unsigned* amax; const float* rs;
    __device__ __forceinline__ void operator()(AccRef acc, const pg8::GUnit& u, int wr, int wc, int, int) const {
        const int ln = opaque_lane(), fr = ln & 15, fq = ln >> 4;
        const int row0 = u.pm * 256 + wr * 64 + fr, c0 = u.pn * 256 + wc * 32 + 8 * fq;
        char* gbu = (char*)G + ((size_t)((u.pm * 16 + u.pn) * 8 + wr * 4 + wc) << 13); const unsigned lo = (unsigned)ln * 8u;
        float rv[2][4];
#pragma unroll
        for (int ai = 0; ai < 2; ++ai)
#pragma unroll
            for (int m = 0; m < 4; ++m) rv[ai][m] = rs[row0 + ai * 128 + m * 16];
        f32x4 bv[2][2], cs[2][2];
#pragma unroll
        for (int bj = 0; bj < 2; ++bj)
#pragma unroll
            for (int n = 0; n < 2; ++n) { bv[bj][n] = *(const f32x4*)(bmg + c0 + bj * 128 + 4 * n); const u32x4 am = *(const u32x4*)(amax + c0 + bj * 128 + 4 * n);
                cs[bj][n] = (f32x4){__uint_as_float(am.x), __uint_as_float(am.y), __uint_as_float(am.z), __uint_as_float(am.w)} * (1.0f / 256.0f); }
#pragma unroll
        for (int ai = 0; ai < 2; ++ai)
#pragma unroll
            for (int m = 0; m < 4; ++m) { const float r_ = rv[ai][m];
#pragma unroll
                for (int bj = 0; bj < 2; ++bj) { const f32x4 v0 = (acc[ai][bj][m][0] * r_) * cs[bj][0] + bv[bj][0], v1 = (acc[ai][bj][m][1] * r_) * cs[bj][1] + bv[bj][1];
                    const f32x2 r0 = act2<ACT_SIGM>((f32x2){v0[0], v0[1]}), r1 = act2<ACT_SIGM>((f32x2){v0[2], v0[3]}), r2 = act2<ACT_SIGM>((f32x2){v1[0], v1[1]}), r3 = act2<ACT_SIGM>((f32x2){v1[2], v1[3]});
                    const f32x2 t0 = r0 * 255.0f + 8388608.0f, t1 = r1 * 255.0f + 8388608.0f, t2 = r2 * 255.0f + 8388608.0f, t3 = r3 * 255.0f + 8388608.0f;
                    u32x2 w;
                    w.x = __builtin_amdgcn_perm(__builtin_amdgcn_perm(__float_as_uint(t1.y), __float_as_uint(t1.x), 0x0c0c0400u), __builtin_amdgcn_perm(__float_as_uint(t0.y), __float_as_uint(t0.x), 0x0c0c0400u), 0x05040100u);
                    w.y = __builtin_amdgcn_perm(__builtin_amdgcn_perm(__float_as_uint(t3.y), __float_as_uint(t3.x), 0x0c0c0400u), __builtin_amdgcn_perm(__float_as_uint(t2.y), __float_as_uint(t2.x), 0x0c0c0400u), 0x05040100u);
                    __builtin_nontemporal_store(w, (u32x2*)(gbu + (lo + (unsigned)(((ai * 4 + m) * 2 + bj) * 512)))); } }
    }
};
struct EpiNull {
    static constexpr bool PERM = true;
    __device__ __forceinline__ void operator()(AccRef acc, const pg8::GUnit&, int, int, int, int) const {
#pragma unroll
        for (int ai = 0; ai < 2; ++ai)
#pragma unroll
            for (int bj = 0; bj < 2; ++bj)
                asm volatile("" :: "v"(acc[ai][bj][0][0]), "v"(acc[ai][bj][0][1]), "v"(acc[ai][bj][1][0]), "v"(acc[ai][bj][1][1]), "v"(acc[ai][bj][2][0]), "v"(acc[ai][bj][2][1]), "v"(acc[ai][bj][3][0]), "v"(acc[ai][bj][3][1]));
    }
};
struct EpiP3 {
    static constexpr bool PERM = true;
    const bf16_t* G; bf16_t* merged; unsigned char* part;
    __device__ __forceinline__ void operator()(AccRef acc, const pg8::GUnit& u, int wr, int wc, int, int) const {
        const int ln = opaque_lane(); const int br = u.br;
        const char* gb = (const char*)G + ((size_t)((u.pm * 16 + br * 4 + u.pn) * 8 + wr * 4 + wc) << 13); const unsigned lo = (unsigned)ln * 16u;
        char* sb = (char*)part + ((size_t)((u.pm * 4 + u.pn) * 8 + wr * 4 + wc) << 14);
#pragma unroll
        for (int ai = 0; ai < 2; ++ai) {
            u32x2 gw[4][2]; u32x4 pw[4][2];
#pragma unroll
            for (int m = 0; m < 4; ++m)
#pragma unroll
                for (int bj = 0; bj < 2; ++bj) { const unsigned q = lo + (unsigned)(((ai * 4 + m) * 2 + bj) * 1024);
                    gw[m][bj] = __builtin_nontemporal_load((const u32x2*)(gb + ((lo >> 1) + (unsigned)(((ai * 4 + m) * 2 + bj) * 512))));
                    if (br > 0) pw[m][bj] = *(const u32x4*)(sb + q); }
#pragma unroll
            for (int m = 0; m < 4; ++m)
#pragma unroll
                for (int bj = 0; bj < 2; ++bj) { const unsigned q = lo + (unsigned)(((ai * 4 + m) * 2 + bj) * 1024);
                    const unsigned gx = gw[m][bj].x, gy = gw[m][bj].y;
                    const float g[8] = {(float)(gx & 0xffu), (float)((gx >> 8) & 0xffu), (float)((gx >> 16) & 0xffu), (float)(gx >> 24),
                                        (float)(gy & 0xffu), (float)((gy >> 8) & 0xffu), (float)((gy >> 16) & 0xffu), (float)(gy >> 24)};
                    const f32x4 v0 = acc[ai][bj][m][0], v1 = acc[ai][bj][m][1];
                    float f[8] = {v0[0] * g[0], v0[1] * g[1], v0[2] * g[2], v0[3] * g[3], v1[0] * g[4], v1[1] * g[5], v1[2] * g[6], v1[3] * g[7]};
                    if (br > 0) { float p_[8]; unpack8(pw[m][bj], p_);
#pragma unroll
                        for (int j = 0; j < 8; ++j) f[j] += p_[j]; }
                    if (br < 3) *(u32x4*)(sb + q) = pack8(f);
                    else { const int fr = ln & 15, fq = ln >> 4; *(u32x4*)(merged + (size_t)(u.pm * 256 + wr * 64 + fr + ai * 128 + m * 16) * 1024 + u.pn * 256 + wc * 32 + 8 * fq + bj * 128) = pack8(f); } }
        }
    }
};
struct EpiP4 {
    static constexpr bool PERM = false;
    const float* xin; float* out;
    __device__ __forceinline__ void operator()(AccRef acc, const pg8::GUnit& u, int wr, int wc, int fr, int fq) const {
        const int row0 = u.pm * 256 + wr * 64 + fr, c0 = u.pn * 256 + wc * 32 + 4 * fq;
#pragma unroll
        for (int ai = 0; ai < 2; ++ai) {
            f32x4 xv[4][2][2];
#pragma unroll
            for (int m = 0; m < 4; ++m)
#pragma unroll
                for (int bj = 0; bj < 2; ++bj)
#pragma unroll
                    for (int n = 0; n < 2; ++n) xv[m][bj][n] = __builtin_nontemporal_load((const f32x4*)(xin + (size_t)(row0 + ai * 128 + m * 16) * 1024 + c0 + bj * 128 + n * 16));
#pragma unroll
            for (int m = 0; m < 4; ++m)
#pragma unroll
                for (int bj = 0; bj < 2; ++bj)
#pragma unroll
                    for (int n = 0; n < 2; ++n) *(f32x4*)(out + (size_t)(row0 + ai * 128 + m * 16) * 1024 + c0 + bj * 128 + n * 16) = xv[m][bj][n] + acc[ai][bj][m][n];
        }
    }
};
struct SchedTiles {
    pg8::StaticOrder so; const char* A; const char* B; size_t tA, tB;
    __device__ __forceinline__ bool next(int i, pg8::GUnit& u) const { pg8::Unit t; if (!so.next(i, t)) return false; u.pm = t.pm; u.pn = t.pn; u.br = 0; u.A = A + (size_t)t.pm * tA; u.B = B + (size_t)t.pn * tB; return true; }
};
struct SchedP3 {
    pg8::StaticOrder so; const char* Y[4]; const char* Wbo; size_t tA;
    __device__ __forceinline__ bool next(int i, pg8::GUnit& u) const { pg8::Unit t; if (!so.next(i >> 2, t)) return false; const int br = i & 3; u.pm = t.pm; u.pn = t.pn; u.br = br;
        const char* y = br == 0 ? Y[0] : br == 1 ? Y[1] : br == 2 ? Y[2] : Y[3];
        u.A = y + (size_t)t.pm * tA; u.B = Wbo + ((size_t)br * 1024 + (size_t)t.pn * 256) * 512 * 2; return true; }
};

namespace moba {
constexpr int D = 128, NW = 8, QBLK = 32, KVBLK = 64, QB = NW * QBLK, LDQ = 2048, LDO = 512;
constexpr int SHM_V = KVBLK * D * 2, SHM_K = KVBLK * D * 2;
constexpr int LDS_NEED = 2 * SHM_V + 2 * SHM_K + NW * 64 * 4;
constexpr float SCALE = 0.08838834764831845f, THR = 8.f;
typedef short s16x4 __attribute__((ext_vector_type(4)));
typedef float f32x16 __attribute__((ext_vector_type(16)));
#define KSWZ(row, colB) ((row) * 256 + ((colB) ^ (((row) & 7) << 4)))
#define SBAR() __builtin_amdgcn_sched_barrier(0)
__device__ __forceinline__ int v_st(int k, int c) { const int kk = (k & ~0xC) | ((k & 4) << 1) | ((k & 8) >> 1); return ((kk >> 3) * 4 + (c >> 5)) * 512 + ((kk & 7) * 32 + (c & 31)) * 2; }
__device__ __forceinline__ int v_rd_base(int lane) { return ((lane & 3) << 3) | (((lane >> 2) & 3) << 6) | (((lane >> 4) & 1) << 5) | (((lane >> 5) & 1) << 8); }
constexpr int v_rd_off(int d0, int ks, int half) { return d0 * 512 + ks * 4096 + half * 2048; }
__device__ __forceinline__ int crow(int r, int hi) { return (r & 3) + 8 * (r >> 2) + 4 * hi; }
__device__ __forceinline__ unsigned cvtpk(float lo, float hi) { unsigned r; asm volatile("v_cvt_pk_bf16_f32 %0, %1, %2" : "=v"(r) : "v"(lo), "v"(hi)); return r; }
__device__ __forceinline__ bf16x8 load8(const bf16_t* p) { return *reinterpret_cast<const bf16x8*>(p); }
typedef __bf16 bf16x2_t __attribute__((ext_vector_type(2)));
__device__ __forceinline__ unsigned cvtpk_s(float lo, float hi) { f32x2 v = {lo, hi}; bf16x2_t b = __builtin_convertvector(v, bf16x2_t); return __builtin_bit_cast(unsigned, b); }

__device__ __forceinline__ float fma_1(float a, float b, float c) { float d; asm("v_fma_f32 %0, %1, %2, %3" : "=v"(d) : "v"(a), "v"(b), "v"(c)); return d; }
__device__ __forceinline__ void mask_causal(f32x16& p0, f32x16& p1, int dq) {
    const float NEG = -__builtin_inff();
#pragma unroll
    for (int r = 0; r < 16; ++r) { const int c = (r & 3) + 8 * (r >> 2); if (dq - c < 0) p0[r] = NEG; if (dq - c - 32 < 0) p1[r] = NEG; }
}
template <int R> __device__ __forceinline__ float alibi_1(float sl, float pv) { constexpr int CB = __builtin_bit_cast(int, (float)((R & 3) + 8 * (R >> 2))); float d;
    asm("v_fmamk_f32 %0, %1, %2, %3" : "=v"(d) : "v"(sl), "n"(CB), "v"(pv)); return d; }
__device__ __forceinline__ void alibi_add(f32x16& p0, f32x16& p1, float slopeR) {
#define AL1(R) p0[R] = alibi_1<R>(slopeR, p0[R]); p1[R] = alibi_1<R>(slopeR, p1[R]);
    AL1(1) AL1(2) AL1(3) AL1(4) AL1(5) AL1(6) AL1(7) AL1(8) AL1(9) AL1(10) AL1(11) AL1(12) AL1(13) AL1(14) AL1(15)
#undef AL1
}
__device__ __forceinline__ void partialSM(f32x16& p0, f32x16& p1, float& m_reg, float& mn, float& alpha, float tb0, float tb1, bool keep) {
    float pm0 = p0[0], pm1 = p1[0];
#pragma unroll
    for (int r = 1; r < 16; ++r) { pm0 = fmaxf(pm0, p0[r]); pm1 = fmaxf(pm1, p1[r]); }
    tb0 = keep ? tb0 : -__builtin_inff(); tb1 = keep ? tb1 : -__builtin_inff();
    float pmax = fmaxf(pm0 + tb0, pm1 + tb1);
    { auto rr = __builtin_amdgcn_permlane32_swap(__float_as_uint(pmax), __float_as_uint(pmax), false, false);
      pmax = fmaxf(__uint_as_float(rr[0]), __uint_as_float(rr[1])); }
    constexpr float C2 = 1.4426950408889634f * SCALE;
    if (__builtin_expect(__all((pmax - m_reg) * SCALE <= THR), 1)) { mn = m_reg; alpha = 1.f; }
    else { mn = fmaxf(m_reg, pmax); alpha = __builtin_amdgcn_exp2f((m_reg - mn) * C2); m_reg = mn; }
    const float mnL0 = (tb0 - mn) * C2, mnL1 = (tb1 - mn) * C2;
#pragma unroll
    for (int r = 0; r < 16; ++r) p0[r] = fma_1(p0[r], C2, mnL0);
#pragma unroll
    for (int r = 0; r < 16; ++r) p1[r] = fma_1(p1[r], C2, mnL1);
#pragma unroll
    for (int r = 0; r < 16; ++r) p0[r] = __builtin_amdgcn_exp2f(p0[r]);
}
__device__ __forceinline__ void finishSM(f32x16& p0, f32x16& p1, float alpha, float& l_reg, bf16x8& pa0, bf16x8& pa1, bf16x8& pa2, bf16x8& pa3) {
#pragma unroll
    for (int r = 0; r < 16; ++r) p1[r] = __builtin_amdgcn_exp2f(p1[r]);
    float ps = 0;
#pragma unroll
    for (int r = 0; r < 16; ++r) ps += p0[r];
#pragma unroll
    for (int r = 0; r < 16; ++r) ps += p1[r];
    { auto rr = __builtin_amdgcn_permlane32_swap(__float_as_uint(ps), __float_as_uint(ps), false, false);
      ps = __uint_as_float(rr[0]) + __uint_as_float(rr[1]); }
    l_reg = l_reg * alpha + ps;
#define PK4(P, B_, OUT) do { unsigned a0 = cvtpk_s(P[B_+0], P[B_+1]), a1 = cvtpk_s(P[B_+2], P[B_+3]);                      \
        unsigned b0 = cvtpk_s(P[B_+4], P[B_+5]), b1 = cvtpk_s(P[B_+6], P[B_+7]);        \
        auto r0 = __builtin_amdgcn_permlane32_swap(a0, b0, false, false); auto r1 = __builtin_amdgcn_permlane32_swap(a1, b1, false, false); \
        u32x4 w = {r0[0], r1[0], r0[1], r1[1]}; OUT = *reinterpret_cast<bf16x8*>(&w); } while (0)
    PK4(p0, 0, pa0); PK4(p0, 8, pa1); PK4(p1, 0, pa2); PK4(p1, 8, pa3);
#undef PK4
}
template <int KB>
__device__ __forceinline__ void qkt(f32x16& p0, f32x16& p1, const char* K_lds, int r32, int hi, const bf16x8* qr) {
    p0 = f32x16{}; p1 = f32x16{};
    const char* kb[4];
#pragma unroll
    for (int dd = 0; dd < 4; ++dd) kb[dd] = K_lds + KB * SHM_K + KSWZ(r32, (dd * 16 + hi * 8) * 2);
#pragma unroll
    for (int d0 = 0; d0 < 8; ++d0) { const char* a = kb[d0 & 3] + (d0 >> 2) * 128;
        bf16x8 b0 = *reinterpret_cast<const bf16x8*>(a);
        bf16x8 b1 = *reinterpret_cast<const bf16x8*>(a + 32 * 256);
        p0 = __builtin_amdgcn_mfma_f32_32x32x16_bf16(b0, qr[d0], p0, 0, 0, 0);
        p1 = __builtin_amdgcn_mfma_f32_32x32x16_bf16(b1, qr[d0], p1, 0, 0, 0); }
}
template <int VB>
__device__ __forceinline__ void pv_tile(f32x16* o, int vb0, bf16x8 pa0, bf16x8 pa1, bf16x8 pa2, bf16x8 pa3) {
#define TRRD(dst, off) asm volatile("ds_read_b64_tr_b16 %0, %1 offset:%2" : "=&v"(dst) : "v"(vb0), "i"(off) : "memory")
#define PV_D0(d0) do { s16x4 l0, l1, l2, l3, h0, h1, h2, h3; constexpr int b_ = VB * SHM_V + v_rd_off(d0, 0, 0); \
        TRRD(l0, b_); TRRD(h0, b_ + 2048); TRRD(l1, b_ + 4096); TRRD(h1, b_ + 6144); TRRD(l2, b_ + 8192); TRRD(h2, b_ + 10240); TRRD(l3, b_ + 12288); TRRD(h3, b_ + 14336); \
        asm volatile("s_waitcnt lgkmcnt(0)" ::: "memory"); SBAR();   \
        o[d0] = __builtin_amdgcn_mfma_f32_32x32x16_bf16(pa0, (bf16x8){l0[0], l0[1], l0[2], l0[3], h0[0], h0[1], h0[2], h0[3]}, o[d0], 0, 0, 0);   \
        o[d0] = __builtin_amdgcn_mfma_f32_32x32x16_bf16(pa1, (bf16x8){l1[0], l1[1], l1[2], l1[3], h1[0], h1[1], h1[2], h1[3]}, o[d0], 0, 0, 0);   \
        o[d0] = __builtin_amdgcn_mfma_f32_32x32x16_bf16(pa2, (bf16x8){l2[0], l2[1], l2[2], l2[3], h2[0], h2[1], h2[2], h2[3]}, o[d0], 0, 0, 0);   \
        o[d0] = __builtin_amdgcn_mfma_f32_32x32x16_bf16(pa3, (bf16x8){l3[0], l3[1], l3[2], l3[3], h3[0], h3[1], h3[2], h3[3]}, o[d0], 0, 0, 0); } while (0)
    PV_D0(0); PV_D0(1); PV_D0(2); PV_D0(3);
#undef PV_D0
#undef TRRD
}

struct BlockRef { const bf16_t* Q; const bf16_t* K; const bf16_t* V; const bf16_t* Z; bf16_t* O; const float* KM; int qb; float slopeR;
                  int jlo, ntp;
                  float* part; unsigned* cnt; };
struct Seam { bf16x8 qr[8]; bf16x8 st_v0, st_v1, st_k0, st_k1; };

#define VMW() asm volatile("s_waitcnt vmcnt(0)" ::: "memory")
#define VMWN(n) asm volatile("s_waitcnt vmcnt(%0)" :: "i"(n) : "memory")
#define SLOAD_H(Kp, Vp, k0) do { const char* kq_ = (const char*)((Kp) + (size_t)(k0) * LDQ); const char* vq_ = (const char*)((Vp) + (size_t)(k0) * LDQ);   \
        S.st_v0 = *(const bf16x8*)(vq_ + soff); S.st_v1 = *(const bf16x8*)(vq_ + (size_t)32 * LDQ * 2 + soff); S.st_k0 = *(const bf16x8*)(kq_ + soff); S.st_k1 = *(const bf16x8*)(kq_ + (size_t)32 * LDQ * 2 + soff); } while (0)
#define SWRITE_HK(bf) do { *(bf16x8*)(K_lds + (bf) * SHM_K + kws) = S.st_k0; *(bf16x8*)(K_lds + (bf) * SHM_K + kws + 32 * 256) = S.st_k1; } while (0)
#define SWRITE_HV(bf) do { *(bf16x8*)(V_lds + (bf) * SHM_V + vst0) = S.st_v0; *(bf16x8*)(V_lds + (bf) * SHM_V + vst1) = S.st_v1; } while (0)
#define SWRITE_H(bf) do { SWRITE_HV(bf); SWRITE_HK(bf); } while (0)
__device__ __forceinline__ void prime(const BlockRef& cur, char* lds, Seam& S, int tid) {
    const int wid = __builtin_amdgcn_readfirstlane(tid >> 6), lane = tid & 63, r32 = lane & 31, hi = lane >> 5;
    const int sr = tid >> 4, sc = (tid & 15) * 8, kws = KSWZ(sr, sc * 2); char* K_lds = lds + 2 * SHM_V;
    const unsigned soff = (unsigned)(sr * LDQ + sc) * 2u, qoff = (unsigned)((wid * QBLK + r32) * LDQ + hi * 8) * 2u;
#pragma unroll
    for (int d0 = 0; d0 < 8; ++d0) S.qr[d0] = *(const bf16x8*)((const char*)cur.Q + qoff + d0 * 32);
    SLOAD_H(cur.K, cur.V, (cur.jlo + cur.ntp - 1) * KVBLK); VMW(); SWRITE_HK(0);
    __syncthreads();
}
__device__ __forceinline__ unsigned select_blocks(const Seam& S, const float* KM, int qb, int hi, int r32) {
    if (qb <= 3) return (1u << qb) - 1u;
    const int n = r32 & 15; const bool live = r32 < 16 && n < qb;
    const float* km = KM + (size_t)(live ? n : 0) * 512 + hi * 8;
    f32x4 kv[8][2];
#pragma unroll
    for (int d0 = 0; d0 < 8; ++d0) { kv[d0][0] = *(const f32x4*)(km + d0 * 16); kv[d0][1] = *(const f32x4*)(km + d0 * 16 + 4); }
    f32x16 p = {};
#pragma unroll
    for (int d0 = 0; d0 < 8; ++d0) { u32x4 w; w.x = pk2(kv[d0][0].x, kv[d0][0].y); w.y = pk2(kv[d0][0].z, kv[d0][0].w); w.z = pk2(kv[d0][1].x, kv[d0][1].y); w.w = pk2(kv[d0][1].z, kv[d0][1].w);
        if (!live) w = (u32x4){0u, 0u, 0u, 0u};
        p = __builtin_amdgcn_mfma_f32_32x32x16_bf16(__builtin_bit_cast(bf16x8, w), S.qr[d0], p, 0, 0, 0); }
    float g[16];
#pragma unroll
    for (int r = 0; r < 8; ++r) { const float own = p[r];
        auto rr = __builtin_amdgcn_permlane32_swap(__float_as_uint(own), __float_as_uint(own), false, false);
        const float oth = __uint_as_float(hi ? rr[0] : rr[1]);
        const int nlo = (r & 3) + 8 * (r >> 2);
        g[nlo] = hi ? oth : own; g[nlo + 4] = hi ? own : oth; }
    unsigned sel = 0u;
#pragma unroll
    for (int it = 0; it < 3; ++it) { float best = -__builtin_inff(); int bi = 0;
#pragma unroll
        for (int n2 = 0; n2 < 15; ++n2) { const bool c = n2 < qb && !((sel >> n2) & 1u) && g[n2] > best; best = c ? g[n2] : best; bi = c ? n2 : bi; }
        sel |= 1u << bi; }
    return sel;
}
__device__ __forceinline__ void block(const BlockRef& cur, const BlockRef& nxt, unsigned sel, char* lds, Seam& S, int tid) {
    const int wid = __builtin_amdgcn_readfirstlane(tid >> 6), lane = tid & 63, r32 = lane & 31, hi = lane >> 5;
    const int qb = cur.qb, NTF = 4 * (qb + 1), NT = cur.ntp, jlo = cur.jlo;
    const int qlo = wid * QBLK, qm = qlo + r32 - 4 * hi;
    char* V_lds = lds; char* K_lds = lds + 2 * SHM_V;
    float* ws = (float*)(lds + 2 * SHM_V + 2 * SHM_K) + wid * 64; float* li_l = ws, * al_l = ws + 32;
    float m_reg = -1e30f, l_reg = 0; f32x16 o[4] = {};
    const int sr = tid >> 4, sc = (tid & 15) * 8, vst0 = v_st(sr, sc), vst1 = v_st(32 + sr, sc), kws = KSWZ(sr, sc * 2);
    const unsigned soff = (unsigned)(sr * LDQ + sc) * 2u, qoff = (unsigned)((wid * QBLK + r32) * LDQ + hi * 8) * 2u;
    const int vb0 = (int)(uintptr_t)V_lds + v_rd_base(lane);
    const bf16_t* Kh = cur.K; const bf16_t* Vh = cur.V;
    const float slopeR = cur.slopeR, hb = slopeR * (float)(4 * hi);
#define RESC(a) do { if (__any((a) < 1.f)) { if (hi == 0) al_l[r32] = (a); asm volatile("s_waitcnt lgkmcnt(0)" ::: "memory");              \
                     for (int d_ = 0; d_ < 4; ++d_) for (int r = 0; r < 16; ++r) o[d_][r] *= al_l[crow(r, hi)]; } } while (0)
#define TIDX(t) (jlo + NT - 1 - (t))
#define KBASE(t) (TIDX(t) * KVBLK)
#define MASKT(P0_, P1_, t) do { const int kr_ = KBASE(t) - 256 * qb; alibi_add(P0_, P1_, slopeR);                                              \
        if (TIDX(t) >= NTF - 4) { if (kr_ + KVBLK - 1 > qlo) mask_causal(P0_, P1_, qm - kr_); }                                                \
        keep_ = (TIDX(t) >= NTF - 4) || (((sel >> (TIDX(t) >> 2)) & 1u) != 0u);                                                                \
        tb0_ = fmaf(slopeR, (float)kr_, hb); tb1_ = tb0_ + 32.f * slopeR; } while (0)
    constexpr int NQL = 8;
#define SEAM_K0() do { VMWN(NQL); SWRITE_HK(0); SBAR(); } while (0)
    f32x16 pA0, pA1, pB0, pB1; float mnA, mnB, alA, alB; bf16x8 pa0, pa1, pa2, pa3; float tb0_, tb1_; bool keep_;
    SWRITE_HV(0); SBAR();
    if (NT > 1) SLOAD_H(Kh, Vh, KBASE(1));
    SBAR(); qkt<0>(pA0, pA1, K_lds, r32, hi, S.qr);
    asm volatile("s_nop 15\n\ts_nop 15" : "+v"(pA0), "+v"(pA1));
    MASKT(pA0, pA1, 0); partialSM(pA0, pA1, m_reg, mnA, alA, tb0_, tb1_, keep_);
    if (NT > 1) { VMW(); SWRITE_H(1); }
    __syncthreads();
#define SGB_QF() do { __builtin_amdgcn_sched_group_barrier(0x100, 2, 0); _Pragma("unroll") for (int i_ = 0; i_ < 8; ++i_) { __builtin_amdgcn_sched_group_barrier(0x100, 2, 0); \
        __builtin_amdgcn_sched_group_barrier(0x8, 1, 0); __builtin_amdgcn_sched_group_barrier(0x400, 1, 0); __builtin_amdgcn_sched_group_barrier(0x2, 3, 0); \
        __builtin_amdgcn_sched_group_barrier(0x8, 1, 0); __builtin_amdgcn_sched_group_barrier(0x400, 1, 0); __builtin_amdgcn_sched_group_barrier(0x2, 3, 0); } } while (0)
#define HALF_STEP(PX0, PX1, mnX, alX, PY0, PY1, alY, t, KB, VB, SB) do {                                                      \
        SBAR(); qkt<KB>(PX0, PX1, K_lds, r32, hi, S.qr);                                                                      \
        finishSM(PY0, PY1, alY, l_reg, pa0, pa1, pa2, pa3); SGB_QF(); SBAR();                                                 \
        if ((t) + 1 < NT) { SLOAD_H(Kh, Vh, KBASE((t) + 1)); SBAR(); }                                                        \
        pv_tile<VB>(o, vb0, pa0, pa1, pa2, pa3); MASKT(PX0, PX1, (t)); partialSM(PX0, PX1, m_reg, mnX, alX, tb0_, tb1_, keep_);      \
        __syncthreads();                                                                                                      \
        if ((t) + 1 < NT) { VMW(); SWRITE_H(SB); }                                                                            \
        RESC(alX); __syncthreads(); } while (0)
    for (int t = 1; t + 1 < NT; t += 2) {
        HALF_STEP(pB0, pB1, mnB, alB, pA0, pA1, alA, t, 1, 0, 0);
        HALF_STEP(pA0, pA1, mnA, alA, pB0, pB1, alB, t + 1, 0, 1, 1);
    }
    SBAR(); qkt<1>(pB0, pB1, K_lds, r32, hi, S.qr); SBAR();
    SLOAD_H(nxt.K, nxt.V, (nxt.jlo + nxt.ntp - 1) * KVBLK); SBAR();
#pragma unroll
    for (int d0 = 0; d0 < 8; ++d0) S.qr[d0] = *(const bf16x8*)((const char*)nxt.Q + qoff + d0 * 32);
    SBAR();
    finishSM(pA0, pA1, alA, l_reg, pa0, pa1, pa2, pa3); SBAR();
    pv_tile<0>(o, vb0, pa0, pa1, pa2, pa3);
    MASKT(pB0, pB1, NT - 1); partialSM(pB0, pB1, m_reg, mnB, alB, tb0_, tb1_, keep_); __syncthreads(); RESC(alB);
    finishSM(pB0, pB1, alB, l_reg, pa0, pa1, pa2, pa3); SBAR(); pv_tile<1>(o, vb0, pa0, pa1, pa2, pa3);
    SBAR(); SEAM_K0();
    bool do_epi = true;
    if (cur.part) {
        volatile unsigned* flg = (volatile unsigned*)(lds + 2 * SHM_V + 2 * SHM_K + NW * 64 * 4);
        if (tid == 0) flg[0] = __hip_atomic_fetch_add(cur.cnt, 1u, __ATOMIC_RELAXED, __HIP_MEMORY_SCOPE_AGENT);
        __syncthreads();
        const unsigned ticket = flg[0];
        float* pp = cur.part + tid;
        if (ticket == 0u) {
#pragma unroll
            for (int d0 = 0; d0 < 4; ++d0)
#pragma unroll
                for (int r = 0; r < 16; ++r) pp[(d0 * 16 + r) * 512] = o[d0][r];
            pp[64 * 512] = m_reg; pp[65 * 512] = l_reg;
            asm volatile("s_waitcnt vmcnt(0)" ::: "memory"); __syncthreads();
            if (tid == 0) { __builtin_amdgcn_fence(__ATOMIC_RELEASE, "agent"); asm volatile("s_waitcnt vmcnt(0)" ::: "memory");
                __hip_atomic_store(cur.cnt + 1, 1u, __ATOMIC_RELAXED, __HIP_MEMORY_SCOPE_AGENT); }
            do_epi = false;
        } else {
            if (tid == 0) { unsigned sp = 0; while (__hip_atomic_load(cur.cnt + 1, __ATOMIC_RELAXED, __HIP_MEMORY_SCOPE_AGENT) == 0u && ++sp < (1u << 22)) __builtin_amdgcn_s_sleep(2);
                __builtin_amdgcn_fence(__ATOMIC_ACQUIRE, "agent"); asm volatile("s_waitcnt vmcnt(0)" ::: "memory"); }
            __syncthreads();
            constexpr float C2 = 1.4426950408889634f * SCALE;
            float pb0[32];
#pragma unroll
            for (int r = 0; r < 32; ++r) pb0[r] = pp[r * 512];
            const float mb = pp[64 * 512], lb = pp[65 * 512], mm = fmaxf(m_reg, mb);
            const float fa = __builtin_amdgcn_exp2f((m_reg - mm) * C2), fb = __builtin_amdgcn_exp2f((mb - mm) * C2);
            l_reg = l_reg * fa + lb * fb;
            if (hi == 0) { al_l[r32] = fa; li_l[r32] = fb; } asm volatile("s_waitcnt lgkmcnt(0)" ::: "memory");
#pragma unroll
            for (int d0 = 0; d0 < 2; ++d0)
#pragma unroll
                for (int r = 0; r < 16; ++r) o[d0][r] = o[d0][r] * al_l[crow(r, hi)] + pb0[d0 * 16 + r] * li_l[crow(r, hi)];
#pragma unroll
            for (int r = 0; r < 32; ++r) pb0[r] = pp[(32 + r) * 512];
#pragma unroll
            for (int d0 = 2; d0 < 4; ++d0)
#pragma unroll
                for (int r = 0; r < 16; ++r) o[d0][r] = o[d0][r] * al_l[crow(r, hi)] + pb0[(d0 - 2) * 16 + r] * li_l[crow(r, hi)];
            asm volatile("s_waitcnt lgkmcnt(0)" ::: "memory");
        }
    }
    if (do_epi) {
    if (hi == 0) li_l[r32] = l_reg; asm volatile("s_waitcnt lgkmcnt(0)" ::: "memory");
    float rli[16];
#pragma unroll
    for (int r = 0; r < 16; ++r) rli[r] = __builtin_amdgcn_rcpf(li_l[crow(r, hi)]);
    __syncthreads();
    bf16_t* Ow = cur.O + (size_t)(wid * QBLK) * LDO; const bf16_t* Zw = cur.Z + (size_t)(wid * QBLK) * LDQ;
    bf16_t* stg = (bf16_t*)V_lds + wid * 2048;
    int le = lane; asm volatile("" : "+v"(le));
#pragma unroll
    for (int hlf = 0; hlf < 2; ++hlf) {
#pragma unroll
        for (int r = 0; r < 16; ++r) { const int orow = crow(r, hi);
            stg[orow * 64 + r32] = (bf16_t)f2bf(o[2 * hlf][r] * rli[r]); stg[orow * 64 + 32 + r32] = (bf16_t)f2bf(o[2 * hlf + 1][r] * rli[r]); }
        asm volatile("s_waitcnt lgkmcnt(0)" ::: "memory");
#pragma unroll
        for (int i = 0; i < 4; ++i) { const int row = i * 8 + (le >> 3), ch = le & 7;
            float ov[8], zv[8]; unpack8(*(const u32x4*)(stg + row * 64 + ch * 8), ov); unpack8(*(const u32x4*)(Zw + (size_t)row * LDQ + hlf * 64 + ch * 8), zv);
#pragma unroll
            for (int j = 0; j < 8; ++j) ov[j] *= zv[j];
            *(u32x4*)(Ow + (size_t)row * LDO + hlf * 64 + ch * 8) = pack8(ov); }
        asm volatile("s_waitcnt lgkmcnt(0)" ::: "memory");
    }
    } else __syncthreads();
    __syncthreads();
#undef RESC
#undef KBASE
#undef TIDX
#undef MASKT
#undef SEAM_K0
#undef HALF_STEP
#undef SGB_QF
}
#undef VMW
#undef VMWN
#undef SLOAD_H
#undef SWRITE_HK
#undef SWRITE_HV
#undef SWRITE_H
__device__ __forceinline__ void mixer_a_chunk(const bf16_t* AV, const bf16_t* UZ, bf16_t* UZOUT, const bf16_t* WA  , const float* lng, const float* lnb, const float* bs  , int chunk, char* lds, int tid) {
    const int wid = __builtin_amdgcn_readfirstlane(tid >> 6), lane = tid & 63, r32 = lane & 31, hi = lane >> 5;
    const int r0 = chunk * 128;
    { float lg[8], lb[8];
#pragma unroll
      for (int j = 0; j < 8; ++j) { lg[j] = lng[lane * 8 + j]; lb[j] = lnb[lane * 8 + j]; }
      char* vdst = lds + (2 * (lane >> 4)) * SHM_V;
      u32x4 rawA[16];
#pragma unroll
      for (int i = 0; i < 16; ++i) rawA[i] = *(const u32x4*)(AV + (size_t)(r0 + wid + NW * i) * 512 + lane * 8);
#pragma unroll
      for (int i = 0; i < 16; ++i) { const int tt = wid + NW * i;
        const u32x4 raw = rawA[i]; float f[8]; unpack8(raw, f);
        float sm = 0.f;
#pragma unroll
        for (int j = 0; j < 8; ++j) sm += f[j];
        const float mean = wave_sum(sm) * (1.0f / 512.0f); float q = 0.f;
#pragma unroll
        for (int j = 0; j < 8; ++j) { f[j] -= mean; q += f[j] * f[j]; }
        const float rstd = 1.0f / sqrtf(wave_sum(q) * (1.0f / 512.0f) + EPS);
#pragma unroll
        for (int j = 0; j < 8; ++j) f[j] = f[j] * rstd * lg[j] + lb[j];
        *(u32x4*)(vdst + (tt >> 6) * SHM_V + v_st(tt & 63, (lane & 15) * 8)) = pack8(f);
      } }
    __syncthreads();
    bf16_t* stg = (bf16_t*)(lds + 131072) + wid * 1024;
#pragma unroll 1
    for (int ti = 0; ti < 2; ++ti) {
        const int task = wid + 8 * ti, g = task & 3, rb = task >> 2;
        f32x16 o[4] = {};
        const bf16_t* wrow = WA + ((size_t)g * 128 + 32 * rb + r32) * 128 + 8 * hi;
        bf16x8 pa[2][4];
#pragma unroll
        for (int tile = 0; tile < 2; ++tile)
#pragma unroll
            for (int k4 = 0; k4 < 4; ++k4) pa[tile][k4] = load8(wrow + 64 * (tile <= (rb >> 1) ? tile : 0) + 16 * k4);
        float bsv[16];
#pragma unroll
        for (int r = 0; r < 16; ++r) bsv[r] = bs[g * 128 + 32 * rb + crow(r, hi)];
        u32x4 uzv[4][2];
#pragma unroll
        for (int d0 = 0; d0 < 4; ++d0)
#pragma unroll
            for (int i = 0; i < 2; ++i) { const int pc = lane + 64 * i; uzv[d0][i] = *(const u32x4*)(UZ + (size_t)(r0 + 32 * rb + (pc >> 2)) * 512 + g * 128 + d0 * 32 + (pc & 3) * 8); }
        { const int vb = (int)(uintptr_t)lds + (2 * g) * SHM_V + v_rd_base(lane); pv_tile<0>(o, vb, pa[0][0], pa[0][1], pa[0][2], pa[0][3]); }
        if (rb >> 1) { const int vb = (int)(uintptr_t)lds + (2 * g + 1) * SHM_V + v_rd_base(lane); pv_tile<0>(o, vb, pa[1][0], pa[1][1], pa[1][2], pa[1][3]); }
#pragma unroll
        for (int d0 = 0; d0 < 4; ++d0) {
#pragma unroll
            for (int r = 0; r < 16; ++r) stg[crow(r, hi) * 32 + r32] = (bf16_t)f2bf(o[d0][r] + bsv[r]);
            asm volatile("s_waitcnt lgkmcnt(0)" ::: "memory");
#pragma unroll
            for (int i = 0; i < 2; ++i) { const int pc = lane + 64 * i, row = pc >> 2, ch = pc & 3;
                float mv[8], uv[8]; unpack8(*(const u32x4*)(stg + row * 32 + ch * 8), mv);
                const size_t uo = (size_t)(r0 + 32 * rb + row) * 512 + g * 128 + d0 * 32 + ch * 8; unpack8(uzv[d0][i], uv);
#pragma unroll
                for (int j = 0; j < 8; ++j) uv[j] *= mv[j];
                *(u32x4*)(UZOUT + uo) = pack8(uv); }
            asm volatile("s_waitcnt lgkmcnt(0)" ::: "memory");
        }
    }
    __syncthreads();
}
constexpr int GCH = 4, NGRP = SEQ / 64 / GCH;
constexpr int GL_QT = 0, GL_KT = 9216, GL_KD = 18432, GL_VT = 34816, GL_SB = 51200, GL_EB = 83968, GL_W2 = 84224, GL_END = 88320;
__device__ __forceinline__ void gla_local(const bf16_t* CQK, const bf16_t* CV, const float* LRF  , const float* w2  , const float* b2  , bf16_t* OL  , bf16_t* QTO  , float* BLO  , float* TT  , float* DGO  ,
                                          int bl, int h, int g, char* lds, int tid) {
    const int wid = __builtin_amdgcn_readfirstlane(tid >> 6), lane = tid & 63, r32 = lane & 31, hi = lane >> 5;
    const int x = wid >> 2, vb = wid & 3;
    const int sr = tid >> 4, sc = (tid & 15) * 8;
    const int ldsb = (int)(uintptr_t)lds;
    f32x16 S = {}; bf16x8 sfr0 = {}, sfr1 = {};
    float dgs[8];
#pragma unroll
    for (int j = 0; j < 8; ++j) dgs[j] = 0.f;
    f32x4 lrA[2][4]; u32x4 qvA[2], kvA[2], vv0A[2], vv1A[2];
    { float* w2s = (float*)(lds + GL_W2);
      for (int i = tid; i < 16 * 64; i += 512) w2s[i] = w2[(i >> 6) * 256 + h * 64 + (i & 63)]; }
    float b2v[8];
#pragma unroll
    for (int j = 0; j < 8; ++j) b2v[j] = b2[h * 64 + 8 * wid + j];
#define GLA_LOAD(c, st) do { const size_t row0_ = (size_t)bl * SEQ + (size_t)(g * GCH + (c)) * 64;                                       \
        const f32x4* lp_ = (const f32x4*)(LRF + (row0_ + lane) * 16); lrA[st][0] = lp_[0]; lrA[st][1] = lp_[1]; lrA[st][2] = lp_[2]; lrA[st][3] = lp_[3];  \
        const bf16_t* qp_ = CQK + (row0_ + lane) * 512 + h * 64 + 8 * wid; qvA[st] = *(const u32x4*)qp_; kvA[st] = *(const u32x4*)(qp_ + 256);  \
        const bf16_t* vp_ = CV + (row0_ + sr) * 512 + h * 128 + sc; vv0A[st] = *(const u32x4*)vp_; vv1A[st] = *(const u32x4*)(vp_ + 32 * 512); } while (0)
    GLA_LOAD(0, 0); GLA_LOAD(1, 1);
    __syncthreads();
#pragma unroll
    for (int c = 0; c < GCH; ++c) {
        const size_t row0 = (size_t)bl * SEQ + (size_t)(g * GCH + c) * 64;
        const f32x4 lr0 = lrA[c & 1][0], lr1 = lrA[c & 1][1], lr2 = lrA[c & 1][2], lr3 = lrA[c & 1][3]; const u32x4 qv = qvA[c & 1], kv = kvA[c & 1], vv0 = vv0A[c & 1], vv1 = vv1A[c & 1];
        { float b[8];
#define DPP_ADD(v, ctrl, rmask) do { const int t_ = __builtin_amdgcn_update_dpp(0, __builtin_bit_cast(int, v), ctrl, rmask, 0xf, false); v += __builtin_bit_cast(float, t_); } while (0)
          { const float lr[16] = {lr0.x, lr0.y, lr0.z, lr0.w, lr1.x, lr1.y, lr1.z, lr1.w, lr2.x, lr2.y, lr2.z, lr2.w, lr3.x, lr3.y, lr3.z, lr3.w};
            float xs[8];
#pragma unroll
            for (int j = 0; j < 8; ++j) xs[j] = b2v[j];
            const float* w2s = (const float*)(lds + GL_W2) + 8 * wid;
#pragma unroll
            for (int r = 0; r < 16; ++r) { const f32x4 wa = *(const f32x4*)(w2s + r * 64), wb = *(const f32x4*)(w2s + r * 64 + 4);
                xs[0] += lr[r] * wa.x; xs[1] += lr[r] * wa.y; xs[2] += lr[r] * wa.z; xs[3] += lr[r] * wa.w; xs[4] += lr[r] * wb.x; xs[5] += lr[r] * wb.y; xs[6] += lr[r] * wb.z; xs[7] += lr[r] * wb.w; }
#pragma unroll
            for (int j = 0; j < 8; ++j) b[j] = (fminf(xs[j], 0.f) * 1.4426950408889634f - __builtin_amdgcn_logf(1.0f + __builtin_amdgcn_exp2f(-fabsf(xs[j]) * 1.4426950408889634f))) * (1.0f / 16.0f); }
#pragma unroll
          for (int j = 0; j < 8; ++j) { float v_ = b[j];
              DPP_ADD(v_, 0x111, 0xf); DPP_ADD(v_, 0x112, 0xf); DPP_ADD(v_, 0x114, 0xf); DPP_ADD(v_, 0x118, 0xf); DPP_ADD(v_, 0x142, 0xa); DPP_ADD(v_, 0x143, 0xc); b[j] = v_; }
#undef DPP_ADD
          float qf_[8], kf_[8], qt[8], kt[8], kd[8], blv[8]; unpack8(qv, qf_); unpack8(kv, kf_);
#pragma unroll
          for (int j = 0; j < 8; ++j) { const float bl_ = __builtin_bit_cast(float, __builtin_amdgcn_readlane(__builtin_bit_cast(int, b[j]), 63)); blv[j] = bl_; const float eq = __builtin_amdgcn_exp2f(b[j]), ek = __builtin_amdgcn_exp2f(-b[j]), ed = __builtin_amdgcn_exp2f(bl_ - b[j]);
              qt[j] = qf_[j] * 0.125f * eq; kt[j] = kf_[j] * ek; kd[j] = kf_[j] * ed; }
          if (lane == 63) { float* bo = BLO + (row0 >> 6) * 256 + h * 64 + 8 * wid; float* eb = (float*)(lds + GL_EB) + 8 * wid;
#pragma unroll
              for (int j = 0; j < 8; ++j) { eb[j] = __builtin_amdgcn_exp2f(blv[j]); bo[j] = blv[j]; dgs[j] += blv[j]; } }
          const u32x4 qpk = pack8(qt);
          *(u32x4*)(QTO + (row0 + lane) * 256 + h * 64 + 8 * wid) = qpk;
          *(u32x4*)(lds + GL_QT + lane * 144 + wid * 16) = qpk;
          *(u32x4*)(lds + GL_KT + lane * 144 + wid * 16) = pack8(kt);
          *(u32x4*)(lds + GL_KD + v_st(lane, 8 * wid)) = pack8(kd);
          *(u32x4*)(lds + GL_VT + v_st(sr, sc)) = vv0; *(u32x4*)(lds + GL_VT + v_st(32 + sr, sc)) = vv1; }
        __syncthreads();
        if (c + 2 < GCH) GLA_LOAD(c + 2, c & 1);
        { bf16x8 qf[4];
#pragma unroll
          for (int ks = 0; ks < 4; ++ks) qf[ks] = *(const bf16x8*)(lds + GL_QT + (32 * x + r32) * 144 + (16 * ks + 8 * hi) * 2);
          f32x16 p0 = {}, p1 = {};
#pragma unroll
          for (int ks = 0; ks < 4; ++ks) { const bf16x8 kf = *(const bf16x8*)(lds + GL_KT + r32 * 144 + (16 * ks + 8 * hi) * 2); p0 = __builtin_amdgcn_mfma_f32_32x32x16_bf16(kf, qf[ks], p0, 0, 0, 0); }
          if (x == 1) {
#pragma unroll
              for (int ks = 0; ks < 4; ++ks) { const bf16x8 kf = *(const bf16x8*)(lds + GL_KT + (32 + r32) * 144 + (16 * ks + 8 * hi) * 2); p1 = __builtin_amdgcn_mfma_f32_32x32x16_bf16(kf, qf[ks], p1, 0, 0, 0); } }
          if (x == 0) {
#pragma unroll
              for (int r = 0; r < 16; ++r) p0[r] = (crow(r, hi) <= r32) ? p0[r] : 0.f;
          } else {
#pragma unroll
              for (int r = 0; r < 16; ++r) p1[r] = (crow(r, hi) <= r32) ? p1[r] : 0.f;
          }
          bf16x8 pa0, pa1, pa2, pa3;
#define PK4(P, B_, OUT) do { unsigned a0 = cvtpk_s(P[B_+0], P[B_+1]), a1 = cvtpk_s(P[B_+2], P[B_+3]);                          \
        unsigned b0 = cvtpk_s(P[B_+4], P[B_+5]), b1 = cvtpk_s(P[B_+6], P[B_+7]);                                             \
        auto r0 = __builtin_amdgcn_permlane32_swap(a0, b0, false, false); auto r1 = __builtin_amdgcn_permlane32_swap(a1, b1, false, false); \
        u32x4 w = {r0[0], r1[0], r0[1], r1[1]}; OUT = *reinterpret_cast<bf16x8*>(&w); } while (0)
          PK4(p0, 0, pa0); PK4(p0, 8, pa1); PK4(p1, 0, pa2); PK4(p1, 8, pa3);
#undef PK4
          s16x4 vl[4], vh[4], kl[4], kh[4];
          const int vbase = ldsb + GL_VT + v_rd_base(lane), kbase = ldsb + GL_KD + v_rd_base(lane);
#define TRRDV(dst, base, off) asm volatile("ds_read_b64_tr_b16 %0, %1" : "=&v"(dst) : "v"((base) + (off)) : "memory")
#pragma unroll
          for (int ks = 0; ks < 4; ++ks) { TRRDV(vl[ks], vbase, vb * 512 + ks * 4096); TRRDV(vh[ks], vbase, vb * 512 + ks * 4096 + 2048); TRRDV(kl[ks], kbase, x * 512 + ks * 4096); TRRDV(kh[ks], kbase, x * 512 + ks * 4096 + 2048); }
#undef TRRDV
          asm volatile("s_waitcnt lgkmcnt(0)" ::: "memory"); SBAR();
#define FR8(l_, h_) (bf16x8){l_[0], l_[1], l_[2], l_[3], h_[0], h_[1], h_[2], h_[3]}
          f32x16 o = {};
          o = __builtin_amdgcn_mfma_f32_32x32x16_bf16(pa0, FR8(vl[0], vh[0]), o, 0, 0, 0);
          o = __builtin_amdgcn_mfma_f32_32x32x16_bf16(pa1, FR8(vl[1], vh[1]), o, 0, 0, 0);
          if (x == 1) { o = __builtin_amdgcn_mfma_f32_32x32x16_bf16(pa2, FR8(vl[2], vh[2]), o, 0, 0, 0); o = __builtin_amdgcn_mfma_f32_32x32x16_bf16(pa3, FR8(vl[3], vh[3]), o, 0, 0, 0); }
          if (c > 0) {
              const char* sbp = lds + GL_SB + (c & 1) * 16384 + ((1 - x) * 4 + vb) * 2048 + lane * 16;
              const bf16x8 pf0 = *(const bf16x8*)sbp, pf1 = *(const bf16x8*)(sbp + 1024);
#pragma unroll
              for (int db = 0; db < 2; ++db)
#pragma unroll
                  for (int s2 = 0; s2 < 2; ++s2) {
                      const char* qa = lds + GL_QT + (32 * x + r32) * 144 + (32 * db + 16 * s2 + 4 * hi) * 2;
                      const s16x4 a_lo = *(const s16x4*)qa, a_hi = *(const s16x4*)(qa + 16);
                      const bf16x8 af = FR8(a_lo, a_hi);
                      const bf16x8 sf = (db == x) ? (s2 == 0 ? sfr0 : sfr1) : (s2 == 0 ? pf0 : pf1);
                      o = __builtin_amdgcn_mfma_f32_32x32x16_bf16(af, sf, o, 0, 0, 0);
                  }
          }
          { const float* eb = (const float*)(lds + GL_EB) + 32 * x;
#pragma unroll
            for (int r = 0; r < 16; ++r) S[r] *= eb[crow(r, hi)]; }
#pragma unroll
          for (int ks = 0; ks < 4; ++ks) S = __builtin_amdgcn_mfma_f32_32x32x16_bf16(FR8(kl[ks], kh[ks]), FR8(vl[ks], vh[ks]), S, 0, 0, 0);
#undef FR8
          if (c + 1 < GCH) { u32x4 w0 = {cvtpk_s(S[0], S[1]), cvtpk_s(S[2], S[3]), cvtpk_s(S[4], S[5]), cvtpk_s(S[6], S[7])}, w1 = {cvtpk_s(S[8], S[9]), cvtpk_s(S[10], S[11]), cvtpk_s(S[12], S[13]), cvtpk_s(S[14], S[15])};
            sfr0 = __builtin_bit_cast(bf16x8, w0); sfr1 = __builtin_bit_cast(bf16x8, w1);
            char* sbw = lds + GL_SB + ((c + 1) & 1) * 16384 + wid * 2048 + lane * 16;
            *(bf16x8*)sbw = sfr0; *(bf16x8*)(sbw + 1024) = sfr1; }
          bf16_t* op = OL + (row0 + 32 * x) * 512 + h * 128 + 32 * vb + r32;
#pragma unroll
          for (int r = 0; r < 16; ++r) { const float v_ = o[r], vn = dpp_f(v_, DPP_QX1); if ((r32 & 1) == 0) *(unsigned*)(op + (size_t)crow(r, hi) * 512) = cvtpk_s(v_, vn); }
        }
        __syncthreads();
    }
#undef GLA_LOAD
    if (lane == 63) { float* dp = DGO + (size_t)((bl * 4 + h) * NGRP + g) * 64 + 8 * wid;
#pragma unroll
        for (int j = 0; j < 8; ++j) dp[j] = dgs[j]; }
    { float* tp = TT + ((size_t)((bl * 4 + h) * NGRP + g) * 128 + 32 * vb + r32) * 64 + 32 * x + 4 * hi;
#pragma unroll
      for (int q = 0; q < 4; ++q) *(f32x4*)(tp + 8 * q) = (f32x4){S[4 * q], S[4 * q + 1], S[4 * q + 2], S[4 * q + 3]}; }
}
constexpr int GF_ST = 0, GF_QH = 18432, GF_BG = 55296, GF_TL = 56320, GF_TLP = 264, GF_END = GF_TL + 256 * GF_TLP;
__device__ __forceinline__ void gla_fix(const bf16_t* OL, const bf16_t* QTO, const float* BLO, const float* TT, const float* DGO, const bf16_t* CZ, bf16_t* YOUT, const float* ong, int bl, int h, int g, char* lds, int tid) {
    const int wid = __builtin_amdgcn_readfirstlane(tid >> 6), lane = tid & 63, r32 = lane & 31, hi = lane >> 5;
    const size_t row0 = (size_t)bl * SEQ + (size_t)g * GCH * 64;
    const int tr = tid >> 4, tc = (tid & 15) * 8;
    u32x4 tl[8];
#pragma unroll
    for (int i = 0; i < 8; ++i) tl[i] = *(const u32x4*)(OL + (row0 + tr + 32 * i) * 512 + h * 128 + tc);
    f32x16 o[4] = {};
    if (g > 0) {
        { const int v = tid >> 2, d0 = (tid & 3) * 16;
          float Sg[16];
#pragma unroll
          for (int j = 0; j < 16; ++j) Sg[j] = 0.f;
          for (int gp0 = 0; gp0 < g; gp0 += 4) {
              f32x4 tv[4][4], dv[4][4];
#pragma unroll
              for (int i = 0; i < 4; ++i) if (gp0 + i < g) {
                  const f32x4* tp = (const f32x4*)(TT + ((size_t)((bl * 4 + h) * NGRP + gp0 + i) * 128 + v) * 64 + d0);
                  const f32x4* dp = (const f32x4*)(DGO + (size_t)((bl * 4 + h) * NGRP + gp0 + i) * 64 + d0);
#pragma unroll
                  for (int j4 = 0; j4 < 4; ++j4) { tv[i][j4] = tp[j4]; dv[i][j4] = dp[j4]; } }
#pragma unroll
              for (int i = 0; i < 4; ++i) if (gp0 + i < g) {
#pragma unroll
                  for (int j4 = 0; j4 < 4; ++j4) {
                      Sg[4 * j4] = __builtin_amdgcn_exp2f(dv[i][j4].x) * Sg[4 * j4] + tv[i][j4].x; Sg[4 * j4 + 1] = __builtin_amdgcn_exp2f(dv[i][j4].y) * Sg[4 * j4 + 1] + tv[i][j4].y;
                      Sg[4 * j4 + 2] = __builtin_amdgcn_exp2f(dv[i][j4].z) * Sg[4 * j4 + 2] + tv[i][j4].z; Sg[4 * j4 + 3] = __builtin_amdgcn_exp2f(dv[i][j4].w) * Sg[4 * j4 + 3] + tv[i][j4].w; } }
          }
          float f0[8] = {Sg[0], Sg[1], Sg[2], Sg[3], Sg[4], Sg[5], Sg[6], Sg[7]}, f1[8] = {Sg[8], Sg[9], Sg[10], Sg[11], Sg[12], Sg[13], Sg[14], Sg[15]};
          *(u32x4*)(lds + GF_ST + v * 144 + d0 * 2) = pack8(f0); *(u32x4*)(lds + GF_ST + v * 144 + d0 * 2 + 16) = pack8(f1); }
        if (tid < 64) { float acc = 0.f; float* bgp = (float*)(lds + GF_BG);
#pragma unroll
            for (int c = 0; c < GCH; ++c) { bgp[c * 64 + tid] = acc; acc += BLO[((row0 >> 6) + c) * 256 + h * 64 + tid]; } }
    }
#pragma unroll
    for (int i = 0; i < 8; ++i) { char* d_ = lds + GF_TL + (tr + 32 * i) * GF_TLP + tc * 2; *(u32x2*)d_ = (u32x2){tl[i].x, tl[i].y}; *(u32x2*)(d_ + 8) = (u32x2){tl[i].z, tl[i].w}; }
#pragma unroll
    for (int i = 0; i < 8; ++i) tl[i] = *(const u32x4*)(CZ + (row0 + tr + 32 * i) * 512 + h * 128 + tc);
    __syncthreads();
    if (g > 0) {
        { const int t = tid >> 1, c0 = (tid & 1) * 32; const float* bgp = (const float*)(lds + GF_BG) + (t >> 6) * 64 + c0;
          const bf16_t* qp = QTO + (row0 + t) * 256 + h * 64 + c0;
#pragma unroll
          for (int j = 0; j < 4; ++j) { float qf_[8]; unpack8(*(const u32x4*)(qp + 8 * j), qf_);
              const f32x4 b0 = *(const f32x4*)(bgp + 8 * j), b1 = *(const f32x4*)(bgp + 8 * j + 4);
              qf_[0] *= __builtin_amdgcn_exp2f(b0.x); qf_[1] *= __builtin_amdgcn_exp2f(b0.y); qf_[2] *= __builtin_amdgcn_exp2f(b0.z); qf_[3] *= __builtin_amdgcn_exp2f(b0.w);
              qf_[4] *= __builtin_amdgcn_exp2f(b1.x); qf_[5] *= __builtin_amdgcn_exp2f(b1.y); qf_[6] *= __builtin_amdgcn_exp2f(b1.z); qf_[7] *= __builtin_amdgcn_exp2f(b1.w);
              *(u32x4*)(lds + GF_QH + t * 144 + (c0 + 8 * j) * 2) = pack8(qf_); } }
        __syncthreads();
#pragma unroll
        for (int ks = 0; ks < 4; ++ks) { const bf16x8 qf = *(const bf16x8*)(lds + GF_QH + (32 * wid + r32) * 144 + (16 * ks + 8 * hi) * 2);
#pragma unroll
            for (int blk = 0; blk < 4; ++blk) { const bf16x8 sf = *(const bf16x8*)(lds + GF_ST + (32 * blk + r32) * 144 + (16 * ks + 8 * hi) * 2);
                o[blk] = __builtin_amdgcn_mfma_f32_32x32x16_bf16(sf, qf, o[blk], 0, 0, 0); } }
    }
    char* myrow = lds + GF_TL + (32 * wid + r32) * GF_TLP + 8 * hi;
    float ss = 0.f;
#pragma unroll
    for (int blk = 0; blk < 4; ++blk)
#pragma unroll
        for (int q = 0; q < 4; ++q) { const u32x2 w = *(const u32x2*)(myrow + 64 * blk + 16 * q);
            o[blk][4 * q] += bf_lo(w.x); o[blk][4 * q + 1] += bf_hi(w.x); o[blk][4 * q + 2] += bf_lo(w.y); o[blk][4 * q + 3] += bf_hi(w.y);
            ss += (o[blk][4 * q] * o[blk][4 * q] + o[blk][4 * q + 1] * o[blk][4 * q + 1]) + (o[blk][4 * q + 2] * o[blk][4 * q + 2] + o[blk][4 * q + 3] * o[blk][4 * q + 3]); }
    ss = sum_x32(ss);
    const float rs = 1.0f / sqrtf(ss * (1.0f / 128.0f) + EPS);
    __syncthreads();
#pragma unroll
    for (int i = 0; i < 8; ++i) { char* d_ = lds + GF_TL + (tr + 32 * i) * GF_TLP + tc * 2; *(u32x2*)d_ = (u32x2){tl[i].x, tl[i].y}; *(u32x2*)(d_ + 8) = (u32x2){tl[i].z, tl[i].w}; }
    __syncthreads();
#pragma unroll
    for (int blk = 0; blk < 4; ++blk)
#pragma unroll
        for (int q = 0; q < 4; ++q) { u32x2* zp = (u32x2*)(myrow + 64 * blk + 16 * q); const u32x2 zw = *zp; const f32x4 gv = *(const f32x4*)(ong + 32 * blk + 8 * q + 4 * hi);
            u32x2 yw; yw.x = pk2(o[blk][4 * q] * rs * gv.x * bf_lo(zw.x), o[blk][4 * q + 1] * rs * gv.y * bf_hi(zw.x)); yw.y = pk2(o[blk][4 * q + 2] * rs * gv.z * bf_lo(zw.y), o[blk][4 * q + 3] * rs * gv.w * bf_hi(zw.y));
            *zp = yw; }
    __syncthreads();
#pragma unroll
    for (int i = 0; i < 8; ++i) { const char* s_ = lds + GF_TL + (tr + 32 * i) * GF_TLP + tc * 2; const u32x2 a_ = *(const u32x2*)s_, b_ = *(const u32x2*)(s_ + 8);
        *(u32x4*)(YOUT + (row0 + tr + 32 * i) * 512 + h * 128 + tc) = (u32x4){a_.x, a_.y, b_.x, b_.y}; }
    __syncthreads();
}
#undef KSWZ
#undef SBAR
}

struct Args { const float* in[18]; float* out; unsigned char* ws; int ph_lo, ph_hi; };
enum { I_X = 0, I_NORMG, I_WIN, I_ALNG, I_ALNB, I_ASW, I_ASB, I_BQG, I_BKG, I_CW2, I_CB, I_CONG, I_DCW, I_DCB, I_WBO, I_WMG, I_BMG, I_WOUT };

__device__ __forceinline__ void transpose_item(const float* W, int ldw, int c0, int valid, int k0, bf16_t* dst  , int ldd, LAS float* scr, int lane, float scale = 1.0f) {
#pragma unroll 8
    for (int i = 0; i < 32; ++i) { const int kk = 2 * i + (lane >> 5), n = lane & 31; scr[kk * 33 + n] = (n < valid) ? W[(size_t)(k0 + kk) * ldw + c0 + n] * scale : 0.f; }
    asm volatile("s_waitcnt lgkmcnt(0)" ::: "memory");
    const int c = lane & 7;
#pragma unroll
    for (int j = 0; j < 4; ++j) { const int n = (lane >> 3) + 8 * j; const LAS float* s = scr + (8 * c) * 33 + n;
        u32x4 o; o.x = pk2(s[0 * 33], s[1 * 33]); o.y = pk2(s[2 * 33], s[3 * 33]); o.z = pk2(s[4 * 33], s[5 * 33]); o.w = pk2(s[6 * 33], s[7 * 33]);
        *(u32x4*)(dst + (size_t)n * ldd + 8 * c) = o; }
    asm volatile("s_waitcnt lgkmcnt(0)" ::: "memory");
}
__device__ __forceinline__ void cat_src(int tile, int half, int& mat, int& col, int& valid) {
    mat = 0; valid = 128;
    if (tile < 4) col = half == 0 ? A_OFF + 128 * tile : A_OFF + 1024 + 128 * tile;
    else if (tile < 6) col = A_OFF + 512 + 256 * (tile - 4) + 128 * half;
    else if (tile < 14) col = B_OFF + 256 * (tile - 6) + 128 * half;
    else if (tile < 16) col = C_OFF + 256 * (tile - 14) + 128 * half;
    else if (tile < 18) col = C_OFF + 512 + 256 * (tile - 16) + 128 * half;
    else if (tile < 20) col = C_OFF + 1040 + 256 * (tile - 18) + 128 * half;
    else if (tile < 24) col = half == 0 ? D_OFF + 512 + 128 * (tile - 20) : D_OFF + 1024 + 128 * (tile - 20);
    else if (tile < 28) col = half == 0 ? D_OFF + 128 * (tile - 24) : D_OFF + 1536 + 128 * (tile - 24);
    else { const int q = tile - 28; mat = 1 + (q >> 2); col = 256 * (q & 3) + 128 * half; }
}
__device__ __forceinline__ void phase_prologue(const Args& a, LAS unsigned char* lds, int wave, int lane) {
    LAS float* scr = (LAS float*)(lds + wave * 16384);
    const int gw = blockIdx.x * NWAVES + wave, NGW = gridDim.x * NWAVES;
    constexpr int I_CAT = (NCAT / 32) * 16, I_BO = (4096 / 32) * 8, I_OUT = (1024 / 32) * 16, I_LAYER = I_CAT + I_BO + I_OUT;
    for (int it = gw; it < DEPTH * I_LAYER; it += NGW) {
        const int l = it / I_LAYER; int r = it % I_LAYER;
        unsigned char* wl = a.ws + OFF_W + (size_t)l * W_LAYER_BYTES;
        if (r < I_CAT) {
            const int nb = r >> 4, kb = r & 15, n0 = nb * 32, tile = n0 >> 8, half = (n0 >> 7) & 1, off = n0 & 127;
            int mat, col, valid; cat_src(tile, half, mat, col, valid);
            if (mat != 0) {
                const float* W = a.in[I_WMG] + (size_t)(l * 4 + mat - 1) * 1024 * 1024 + (size_t)(kb * 64 + (lane >> 5)) * 1024 + col + off + (lane & 31);
                float mx = 0.f;
#pragma unroll 8
                for (int i = 0; i < 32; ++i) mx = fmaxf(mx, fabsf(W[(size_t)i * 2048]));
                { auto r2 = __builtin_amdgcn_permlane32_swap(__float_as_uint(mx), __float_as_uint(mx), false, false); mx = fmaxf(__uint_as_float(r2[0]), __uint_as_float(r2[1])); }
                if (lane < 32) atomicMax((unsigned*)(a.ws + OFF_AMAX) + l * 4096 + (n0 - 7168) + lane, __float_as_uint(mx));
                continue;
            }
            int v = valid - off; v = v < 0 ? 0 : (v > 32 ? 32 : v);
            const float* W; int ldw;
            if (mat == 0) { W = a.in[I_WIN] + (size_t)l * 1024 * NIN; ldw = NIN; } else { W = a.in[I_WMG] + (size_t)(l * 4 + mat - 1) * 1024 * 1024; ldw = 1024; }
            transpose_item(W, ldw, col + off, v, kb * 64, (bf16_t*)(wl + WOFF_CAT) + (size_t)n0 * 1024 + kb * 64, 1024, scr, lane);
            continue;
        }
        r -= I_CAT;
        if (r < I_BO) {
            const int nb = r >> 3, kb = r & 7, n0 = nb * 32, br = n0 >> 10, nn = n0 & 1023;
            const float* W = a.in[I_WBO] + (size_t)(l * 4 + br) * 512 * 1024;
            transpose_item(W, 1024, nn, 32, kb * 64, (bf16_t*)(wl + WOFF_BO) + (size_t)n0 * 512 + kb * 64, 512, scr, lane, 1.0f / 255.0f);
            continue;
        }
        r -= I_BO;
        { const int nb = r >> 4, kb = r & 15, n0 = nb * 32;
          const float* W = a.in[I_WOUT] + (size_t)l * 1024 * 1024;
          transpose_item(W, 1024, n0, 32, kb * 64, (bf16_t*)(wl + WOFF_OUT) + (size_t)n0 * 1024 + kb * 64, 1024, scr, lane); }
    }
    for (int idx = gw * 64 + lane; idx < DEPTH * 1024 * 16; idx += NGW * 64) {
        const int l = idx >> 14, c = (idx >> 4) & 1023, r = idx & 15;
        ((float*)(a.ws + OFF_WLR))[(size_t)l * 20480 + (((c >> 8) * 4 + (c & 3)) * 64 + ((c >> 2) & 63)) * 20 + r] = a.in[I_WIN][(size_t)l * 1024 * NIN + (size_t)c * NIN + (C_OFF + 1024) + r];
    }
    for (int idx = gw * 64 + lane; idx < DEPTH * 4 * 128 * 16; idx += NGW * 64) {
        const int t = (idx >> 4) & 127, s0 = (idx & 15) * 8; const float* src = a.in[I_ASW] + (size_t)(idx >> 4) * 128 + s0; float f[8];
#pragma unroll
        for (int j = 0; j < 8; ++j) f[j] = (s0 + j <= t) ? src[j] : 0.f;
        *(u32x4*)((bf16_t*)(a.ws + OFF_WA) + (size_t)(idx >> 4) * 128 + s0) = pack8(f);
    }
}

__device__ __forceinline__ void phase_quant_gates(const Args& a, LAS unsigned char* lds, int wave, int lane) {
    LAS float* scr = (LAS float*)(lds + wave * 16384);
    const int gw = blockIdx.x * NWAVES + wave, NGW = gridDim.x * NWAVES;
    for (int it = gw; it < DEPTH * 128 * 16; it += NGW) {
        const int l = it >> 11, nb = (it >> 4) & 127, kb = it & 15, n0 = nb * 32;
        const float* W = a.in[I_WMG] + (size_t)(l * 4 + (n0 >> 10)) * 1024 * 1024 + (n0 & 1023);
#pragma unroll 8
        for (int i = 0; i < 32; ++i) { const int kk = 2 * i + (lane >> 5), n = lane & 31; scr[kk * 33 + n] = W[(size_t)(kb * 64 + kk) * 1024 + n]; }
        asm volatile("s_waitcnt lgkmcnt(0)" ::: "memory");
        const int c = lane & 3;
        unsigned char* dst = a.ws + OFF_W + (size_t)l * W_LAYER_BYTES + WOFF_G8 + (size_t)n0 * 1024 + kb * 64 + 16 * c;
#pragma unroll
        for (int j = 0; j < 2; ++j) { const int n = (lane >> 2) + 16 * j; const LAS float* s = scr + (16 * c) * 33 + n;
            const float q = 256.0f / fmaxf(__uint_as_float(((const unsigned*)(a.ws + OFF_AMAX))[l * 4096 + n0 + n]), 1e-30f);
            u32x4 o; o.x = pk4_fp8(s[0 * 33] * q, s[1 * 33] * q, s[2 * 33] * q, s[3 * 33] * q); o.y = pk4_fp8(s[4 * 33] * q, s[5 * 33] * q, s[6 * 33] * q, s[7 * 33] * q);
            o.z = pk4_fp8(s[8 * 33] * q, s[9 * 33] * q, s[10 * 33] * q, s[11 * 33] * q); o.w = pk4_fp8(s[12 * 33] * q, s[13 * 33] * q, s[14 * 33] * q, s[15 * 33] * q);
            *(u32x4*)(dst + (size_t)n * 1024) = o; }
        asm volatile("s_waitcnt lgkmcnt(0)" ::: "memory");
    }
}

__device__ __forceinline__ void phase_rmsnorm(const Args& a, int l, int hf, LAS unsigned char* lds, int tid, int wave, int lane) {
    const float* xs = (l == 0 ? a.in[I_X] : a.out) + (size_t)hf * MH * DM;
    bf16_t* H = (bf16_t*)(a.ws + OFF_H); float* LRF = (float*)(a.ws + OFF_LRF);
    { const f32x4* wsrc = (const f32x4*)(a.ws + OFF_WLR) + (size_t)l * 5120;
#pragma unroll
      for (int i = 0; i < 10; ++i) *(LAS f32x4*)(lds + (size_t)(tid + i * NTHREADS) * 16) = wsrc[tid + i * NTHREADS]; }
    __syncthreads();
    const f32x4* gp = (const f32x4*)(a.in[I_NORMG] + l * DM) + lane;
    f32x4 g[4];
#pragma unroll
    for (int j = 0; j < 4; ++j) g[j] = gp[64 * j];
    const int gw = blockIdx.x * NWAVES + wave, NGW = gridDim.x * NWAVES;
    const bool hi5 = (lane & 32) != 0, hi4 = (lane & 16) != 0, hi3 = (lane & 8) != 0, hi2 = (lane & 4) != 0;
    f32x4 vn[4];
    { const f32x4* xr0 = (const f32x4*)(xs + (size_t)(gw < MH ? gw : 0) * DM) + lane;
#pragma unroll
      for (int j = 0; j < 4; ++j) vn[j] = xr0[64 * j]; }
    for (int m = gw; m < MH; m += NGW) {
        f32x4 v[4]; float s = 0.f;
#pragma unroll
        for (int j = 0; j < 4; ++j) v[j] = vn[j];
        { const int mn = (m + NGW < MH) ? m + NGW : m; const f32x4* xr = (const f32x4*)(xs + (size_t)mn * DM) + lane;
#pragma unroll
          for (int j = 0; j < 4; ++j) vn[j] = xr[64 * j]; }
#pragma unroll
        for (int j = 0; j < 4; ++j) s += (v[j].x * v[j].x + v[j].y * v[j].y) + (v[j].z * v[j].z + v[j].w * v[j].w);
        const float r = 1.0f / sqrtf(wave_sum(s) * (1.0f / DM) + EPS);
        u32x2* o = (u32x2*)(H + (size_t)m * DM) + lane;
        { float mx = 0.f;
#pragma unroll
          for (int j = 0; j < 4; ++j) mx = fmaxf(fmaxf(mx, fmaxf(fabsf(v[j].x * g[j].x), fabsf(v[j].y * g[j].y))), fmaxf(fabsf(v[j].z * g[j].z), fabsf(v[j].w * g[j].w)));
          mx = fmaxf(wave_max(mx), 1e-30f); const float q = 256.0f / mx;
          unsigned* o8 = (unsigned*)(a.ws + OFF_H8 + (size_t)m * DM) + lane;
#pragma unroll
          for (int j = 0; j < 4; ++j) o8[64 * j] = pk4_fp8(v[j].x * g[j].x * q, v[j].y * g[j].y * q, v[j].z * g[j].z * q, v[j].w * g[j].w * q);
          if (lane == 0) ((float*)(a.ws + OFF_RS))[m] = r * mx * (1.0f / 256.0f); }
        float p[16];
#pragma unroll
        for (int i = 0; i < 16; ++i) p[i] = 0.f;
        int lw = lane * 20; asm volatile("" : "+v"(lw));
#pragma unroll
        for (int j = 0; j < 4; ++j) { const f32x4 hv = {v[j].x * r * g[j].x, v[j].y * r * g[j].y, v[j].z * r * g[j].z, v[j].w * r * g[j].w};
            u32x2 w; w.x = pk2(hv.x, hv.y); w.y = pk2(hv.z, hv.w); o[64 * j] = w;
#pragma unroll
            for (int e = 0; e < 4; ++e) { const LAS float* wp = (const LAS float*)lds + (j * 4 + e) * 64 * 20 + lw; const float hh = hv[e];
#pragma unroll
                for (int q = 0; q < 4; ++q) { const f32x4 w4 = *(const LAS f32x4*)(wp + 4 * q); p[4 * q] += hh * w4.x; p[4 * q + 1] += hh * w4.y; p[4 * q + 2] += hh * w4.z; p[4 * q + 3] += hh * w4.w; } } }
        float q8[8], q4[4], q2[2], q1;
#pragma unroll
        for (int i = 0; i < 8; ++i) { const float snd = hi5 ? p[i] : p[i + 8], kp = hi5 ? p[i + 8] : p[i]; q8[i] = kp + xchg32(snd, hi5); }
#pragma unroll
        for (int i = 0; i < 4; ++i) { const float snd = hi4 ? q8[i] : q8[i + 4], kp = hi4 ? q8[i + 4] : q8[i]; q4[i] = kp + xchg16(snd, hi4); }
#pragma unroll
        for (int i = 0; i < 2; ++i) { const float snd = hi3 ? q4[i] : q4[i + 2], kp = hi3 ? q4[i + 2] : q4[i]; q2[i] = kp + dpp_f(snd, DPP_ROR8); }
        { const float snd = hi2 ? q2[0] : q2[1], kp = hi2 ? q2[1] : q2[0]; q1 = kp + swz_x4(snd); }
        q1 += dpp_f(q1, DPP_QX1); q1 += dpp_f(q1, DPP_QX2);
        if ((lane & 3) == 0) LRF[(size_t)m * 16 + (hi5 ? 8 : 0) + (hi4 ? 4 : 0) + (hi3 ? 2 : 0) + (hi2 ? 1 : 0)] = q1;
    }
    __syncthreads();
}

__device__ __forceinline__ void mixer_b_prep(const Args& a, int l, int unit, LAS unsigned char* lds, int tid, int wave, int lane) {
    (void)tid;
    bf16_t* PB = (bf16_t*)(a.ws + OFF_PB); float* KM = (float*)(a.ws + OFF_KMEAN);
    const int blkid = unit >> 1, hp = unit & 1;
    const int r0 = (blkid >> 4) * SEQ + (blkid & 15) * 256, l32 = lane & 31, up = lane >> 5;
    float gq[8], gk[8], ks[8];
#pragma unroll
    for (int j = 0; j < 8; ++j) { gq[j] = a.in[I_BQG][l * 128 + (l32 & 15) * 8 + j]; gk[j] = a.in[I_BKG][l * 128 + (l32 & 15) * 8 + j]; ks[j] = 0.f; }
    for (int i0 = 0; i0 < 32; i0 += 16) {
        u32x4 rq[8], rk[8];
#pragma unroll
        for (int u = 0; u < 8; ++u) { const bf16_t* rp = PB + (size_t)(r0 + wave * 32 + i0 + 2 * u + up) * 2048 + hp * 256 + l32 * 8; rq[u] = *(const u32x4*)rp; rk[u] = *(const u32x4*)(rp + 512); }
#pragma unroll
        for (int u = 0; u < 8; ++u) {
            bf16_t* rp = PB + (size_t)(r0 + wave * 32 + i0 + 2 * u + up) * 2048 + hp * 256 + l32 * 8;
            { float f[8]; unpack8(rq[u], f); float ss = 0.f;
#pragma unroll
              for (int j = 0; j < 8; ++j) ss += f[j] * f[j];
              ss = row16_sum(ss);
              const float r = 1.0f / sqrtf(ss * (1.0f / 128.0f) + EPS);
#pragma unroll
              for (int j = 0; j < 8; ++j) f[j] = f[j] * r * gq[j];
              *(u32x4*)rp = pack8(f); }
            { float f[8]; unpack8(rk[u], f); float ss = 0.f;
#pragma unroll
              for (int j = 0; j < 8; ++j) ss += f[j] * f[j];
              ss = row16_sum(ss);
              const float r = 1.0f / sqrtf(ss * (1.0f / 128.0f) + EPS);
#pragma unroll
              for (int j = 0; j < 8; ++j) { f[j] = f[j] * r * gk[j]; ks[j] += f[j]; }
              *(u32x4*)(rp + 512) = pack8(f); }
        }
    }
    LAS float* red = (LAS float*)lds;
#pragma unroll
    for (int j = 0; j < 8; ++j) { const float t_ = sum_x32(ks[j]); if (up == 0) red[wave * 256 + l32 * 8 + j] = t_; }
    __syncthreads();
    if (tid < 256) { float s_ = 0.f;
#pragma unroll
        for (int w = 0; w < 8; ++w) s_ += red[w * 256 + tid];
        KM[(size_t)blkid * 512 + hp * 256 + tid] = s_ * (1.0f / 256.0f); }
    __syncthreads();
}
__device__ __forceinline__ void mixer_d_conv(const Args& a, int l, int tid) {
    const bf16_t* DCX = (const bf16_t*)(a.ws + OFF_DCX); const bf16_t* DBZ = (const bf16_t*)(a.ws + OFF_DBZ); bf16_t* DOUT = (bf16_t*)(a.ws + OFF_YD);
    const int gt = blockIdx.x * NTHREADS + tid, GT = gridDim.x * NTHREADS;
    const float* cw = a.in[I_DCW] + (size_t)l * 3 * BW; const float* cb = a.in[I_DCB] + (size_t)l * BW;
    const int cv = (tid & 63) * 8;
    float w0[8], w1[8], w2[8], bb[8];
#pragma unroll
    for (int j = 0; j < 8; ++j) { w0[j] = cw[cv + j]; w1[j] = cw[BW + cv + j]; w2[j] = cw[2 * BW + cv + j]; bb[j] = cb[cv + j]; }
    constexpr int RUN = 8;
    for (int rb = gt >> 6; rb < MH / RUN; rb += GT >> 6) {
        const int row0 = rb * RUN, t0 = row0 & (SEQ - 1);
        float x1[8], x2[8];
        if (t0 >= 2) { unpack8(*(const u32x4*)(DCX + (size_t)(row0 - 1) * 512 + cv), x1); unpack8(*(const u32x4*)(DCX + (size_t)(row0 - 2) * 512 + cv), x2); }
        else {
#pragma unroll
            for (int j = 0; j < 8; ++j) { x1[j] = 0.f; x2[j] = 0.f; } }
        u32x4 xr[RUN], br[RUN];
#pragma unroll
        for (int i = 0; i < RUN; ++i) { xr[i] = *(const u32x4*)(DCX + (size_t)(row0 + i) * 512 + cv); br[i] = *(const u32x4*)(DBZ + (size_t)(row0 + i) * 512 + cv); }
#pragma unroll
        for (int i = 0; i < RUN; ++i) { float x0[8], bz[8], y[8]; unpack8(xr[i], x0); unpack8(br[i], bz);
#pragma unroll
            for (int j = 0; j < 8; ++j) { y[j] = bz[j] * (w0[j] * x2[j] + w1[j] * x1[j] + w2[j] * x0[j] + bb[j]); x2[j] = x1[j]; x1[j] = x0[j]; }
            *(u32x4*)(DOUT + (size_t)(row0 + i) * 512 + cv) = pack8(y); }
    }
}


__device__ const unsigned ATT_TAB[16] = {0x2cu, 0x2du, 0x1e4u, 0x129u, 0x1463u, 0x520u, 0x29du, 0x5dbu, 0x4a1u, 0x55eu, 0x2au, 0x61au, 0x30u, 0x2fu, 0x3a7u, 0x3e6u};
__device__ const unsigned Z_TAB[16] = {0x4100u, 0x8008u, 0x10u, 0x2u, 0x0u, 0x1u, 0x4u, 0x1000u, 0x40u, 0x80u, 0x2800u, 0x20u, 0x400u, 0x200u, 0x0u, 0x0u};
__device__ __forceinline__ moba::BlockRef moba_ref(const Args& a, int bh, int code, int pass) {
    const int qb = (code - 1) / 3, part = (code - 1) % 3, bl = bh >> 2, h = bh & 3;
    const bf16_t* PB = (const bf16_t*)(a.ws + OFF_PB); const size_t rb = (size_t)bl * SEQ, r0 = rb + (size_t)qb * 256;
    moba::BlockRef r;
    r.Q = PB + r0 * 2048 + h * 128; r.K = PB + rb * 2048 + 512 + h * 128; r.V = PB + rb * 2048 + 1024 + h * 128; r.Z = PB + r0 * 2048 + 1536 + h * 128;
    r.O = (bf16_t*)(a.ws + OFF_YB) + r0 * 512 + h * 128; r.KM = (const float*)(a.ws + OFF_KMEAN) + (size_t)(bl * 64 + h) * 128; r.qb = qb;
    r.slopeR = (h == 0 ? 0.25f : h == 1 ? 0.0625f : h == 2 ? 0.015625f : 0.00390625f) * 11.313708498984761f;
    const int nt = 4 * (qb + 1);
    r.jlo = part == 2 ? nt / 2 : 0; r.ntp = part == 0 ? nt : nt / 2;
    const int su = bh * 12 + (qb - 4);
    r.part = part ? (float*)(a.ws + OFF_ATTP) + (size_t)su * 66 * 512 : nullptr;
    r.cnt = part ? (unsigned*)(a.ws + OFF_CTL) + 4096 + (pass * 192 + su) * 2 : nullptr;
    return r;
}
__device__ __forceinline__ void mixer_b_attn(const Args& a, char* lds, int wave_in, int G, int bid, int pass, int l, size_t off_yc) {
    for (int v = bid; v < 256; v += G) {
        const int tid = opaque_s(wave_in) * 64 + opaque_lane();
        const int xcd = v & 7, k = v >> 3, bh = xcd + 8 * (k & 1), slot = k >> 1;
        const unsigned codes = ATT_TAB[slot];
        int ci = 0; int code = (int)(codes & 63u);
        moba::BlockRef cur = moba_ref(a, bh, code, pass); moba::Seam S; moba::prime(cur, lds, S, tid);
        for (;;) {
            const unsigned sel = moba::select_blocks(S, cur.KM, cur.qb, (tid >> 5) & 1, tid & 31);
            const int ncode = (int)((codes >> (6 * (ci + 1))) & 63u); const bool last = ncode == 0;
            const moba::BlockRef nxt = last ? cur : moba_ref(a, bh, ncode, pass);
            moba::block(cur, nxt, sel, lds, S, tid);
            if (last) break;
            cur = nxt; ++ci;
        }
        unsigned zm = (PROBE_REP == 14 && pass >= 4) ? 0u : Z_TAB[slot];
        while (zm) { const int g = __builtin_ctz(zm); zm &= zm - 1u;
            const int tz = opaque_s(wave_in) * 64 + opaque_lane();
            moba::gla_fix((const bf16_t*)(a.ws + OFF_OL), (const bf16_t*)(a.ws + OFF_QTO), (const float*)(a.ws + OFF_BLO), (const float*)(a.ws + OFF_TT), (const float*)(a.ws + OFF_DGO), (const bf16_t*)(a.ws + OFF_CZ), (bf16_t*)(a.ws + off_yc), a.in[I_CONG] + l * 128, bh >> 2, bh & 3, g, lds, tz); }
    }
}

#define XB_TMO      128
#define XB_XCNT(j)  (256  + 64 * (j))
#define XB_XSUB(j)  (1280 + 64 * (j))
#define XB_XGEN(j)  (2304 + 64 * (j))
#define XB_TOP      3328
#define XB_TOPGEN   3392
#define XCD_BAR_WORDS 3456
#define XB_SPIN_CAP (1u << 18)
__device__ __forceinline__ unsigned xb_ld(unsigned* p)              { return __hip_atomic_load(p, __ATOMIC_RELAXED, __HIP_MEMORY_SCOPE_AGENT); }
__device__ __forceinline__ unsigned xb_add(unsigned* p, unsigned v) { return __hip_atomic_fetch_add(p, v, __ATOMIC_RELAXED, __HIP_MEMORY_SCOPE_AGENT); }
__device__ __forceinline__ unsigned xb_xcc_id() { return (unsigned)__builtin_amdgcn_s_getreg((3 << 11) | 20) & 0xFu; }
#define XB_SPIN(cond, bar) do { unsigned _sp = 0; while (cond) { __builtin_amdgcn_s_sleep(1); \
    if ((++_sp & 255u) == 0u) { if (xb_ld(&(bar)[XB_TMO])) break; if (_sp > XB_SPIN_CAP) { atomicAdd(&(bar)[XB_TMO], 1u); break; } } } } while (0)
struct XcdBarrier { unsigned* bar; unsigned x; volatile LAS unsigned* st; };
__device__ __forceinline__ XcdBarrier xcd_barrier_post(unsigned* bar, volatile LAS unsigned* st) {
    XcdBarrier b; b.bar = bar; b.x = xb_xcc_id(); b.st = st;
    if (threadIdx.x == 0) (void)xb_add(&bar[XB_XCNT(b.x)], 1u);
    return b;
}
__device__ __forceinline__ void xcd_barrier_complete(unsigned* bar, unsigned x, unsigned& nloc, unsigned& nx) {
    const unsigned G = gridDim.x * gridDim.y * gridDim.z;
    unsigned sum, cnt, mine, sp = 0u;
    for (;;) {
        sum = 0u; cnt = 0u; mine = 0u;
#pragma unroll
        for (unsigned j = 0; j < 16; ++j) { const unsigned c = xb_ld(&bar[XB_XCNT(j)]); sum += c; cnt += (c > 0u) ? 1u : 0u; mine = (j == x) ? c : mine; }
        if (sum == G) break;
        __builtin_amdgcn_s_sleep(1);
        if ((++sp & 255u) == 0u) { if (xb_ld(&bar[XB_TMO])) break; if (sp > XB_SPIN_CAP) { atomicAdd(&bar[XB_TMO], 1u); break; } }
    }
    nloc = mine > 0u ? mine : 1u; nx = cnt > 0u ? cnt : 1u;
}
__device__ __forceinline__ void xcd_barrier(const XcdBarrier& b) {
    asm volatile("s_waitcnt vmcnt(0)" ::: "memory");
    __syncthreads();
    if (threadIdx.x == 0) {
        unsigned* bar = b.bar;
        __builtin_amdgcn_s_waitcnt(0);
        unsigned nloc = b.st[0], nx = b.st[1];
        if (nloc == 0u) { xcd_barrier_complete(bar, b.x, nloc, nx); b.st[0] = nloc; b.st[1] = nx; }
        const unsigned old = xb_add(&bar[XB_XSUB(b.x)], 1u);
        const unsigned gen = old / nloc;
        if (old + 1u == (gen + 1u) * nloc) {
            __builtin_amdgcn_fence(__ATOMIC_RELEASE, "agent");
            asm volatile("s_waitcnt vmcnt(0)" ::: "memory");
            const unsigned og = xb_add(&bar[XB_TOP], 1u);
            const unsigned tg = og / nx;
            if (og + 1u == (tg + 1u) * nx) xb_add(&bar[XB_TOPGEN], 1u);
            else XB_SPIN(xb_ld(&bar[XB_TOPGEN]) == tg, bar);
            __builtin_amdgcn_fence(__ATOMIC_ACQUIRE, "agent");
            xb_add(&bar[XB_XGEN(b.x)], 1u);
            asm volatile("s_waitcnt vmcnt(0)" ::: "memory");
        } else {
            XB_SPIN(xb_ld(&bar[XB_XGEN(b.x)]) == gen, bar);
            __builtin_amdgcn_fence(__ATOMIC_ACQUIRE, "agent");
            asm volatile("s_waitcnt vmcnt(0)" ::: "memory");
        }
    }
    __syncthreads();
}

constexpr int PH_PER_PASS = 6 + ((PROBE_REP >= 0 && PROBE_REP != 9 && PROBE_REP < 20) ? 1 : 0), N_PRO = (PROBE_REP == 9 ? 2 : 1), N_PHASES = N_PRO + DEPTH * NSPLIT * PH_PER_PASS;
__device__ __forceinline__ int slot_kind(int slot) {
    if (PROBE_REP < 0 || PROBE_REP == 9 || PROBE_REP >= 20) return slot;
    if (PROBE_REP == 3) return slot < 3 ? slot : (slot == 3 ? 6 : slot - 1);
    if (PROBE_REP == 10) return slot < 2 ? slot : (slot == 2 ? 10 : slot - 1);
    if (PROBE_REP == 11 || (PROBE_REP >= 16 && PROBE_REP <= 18)) return slot <= 2 ? slot : slot - 1;
    if (PROBE_REP == 12 || PROBE_REP == 14) return slot < 3 ? slot : (slot == 3 ? 12 : slot - 1);
    if (PROBE_REP == 13) return slot < 2 ? slot : (slot == 2 ? 13 : slot - 1);
    return slot <= PROBE_REP ? slot : slot - 1;
}
typedef const __attribute__((address_space(4))) Args* KArgs;
__device__ __forceinline__ Args ld_args(KArgs kp) { asm volatile("" : "+s"(kp)); Args r;
#pragma unroll
    for (int i = 0; i < 18; ++i) r.in[i] = kp->in[i];
    r.out = kp->out; r.ws = kp->ws; r.ph_lo = kp->ph_lo; r.ph_hi = kp->ph_hi; return r; }
#define PHASE_ARGS const Args a = ld_args(kp); const int wave = opaque_s(wave0), lane = opaque_lane(), tid = wave * 64 + lane, bid = opaque_s(bid0), G = opaque_s(G0)
__global__ void __launch_bounds__(NTHREADS, 2) fwd_kernel(Args a_) {
    extern __shared__ __attribute__((aligned(16))) unsigned char lds_raw[];
    LAS unsigned char* lds = (LAS unsigned char*)lds_raw;
    const int G0 = gridDim.x, bid0 = blockIdx.x, wave0 = __builtin_amdgcn_readfirstlane(threadIdx.x >> 6);
    KArgs kp = (KArgs)__builtin_amdgcn_kernarg_segment_ptr();
    const int ph_lo = a_.ph_lo, ph_hi = a_.ph_hi;
    volatile LAS unsigned* bst = (volatile LAS unsigned*)(lds + 147456);
    if (threadIdx.x < 16) bst[threadIdx.x] = 0u;
    __syncthreads();
    XcdBarrier gbar; gbar.bar = (unsigned*)(a_.ws + OFF_CTL); gbar.x = 0; gbar.st = bst;
    if (ph_hi - ph_lo > 1) gbar = xcd_barrier_post((unsigned*)(a_.ws + OFF_CTL), bst);
    for (int ph = ph_lo; ph < ph_hi; ++ph) {
        if (ph < N_PRO) { PHASE_ARGS; phase_prologue(a, lds, wave, lane);
        }
        else {
            const int p = ph - N_PRO, l = p / (NSPLIT * PH_PER_PASS), hf = (p / PH_PER_PASS) % NSPLIT, s = slot_kind(p % PH_PER_PASS);
            if (MERGE_S0 && PROBE_REP != 0 && s == 0 && (l | hf) != 0) continue;
            if (s == 0) { PHASE_ARGS; if ((l | hf) == 0) { phase_quant_gates(a, lds, wave, lane); __syncthreads(); } phase_rmsnorm(a, l, hf, lds, tid, wave, lane); }
            else if (s == 1) {
                PHASE_ARGS; (void)lane; unsigned char* wl = a.ws + OFF_W + (size_t)l * W_LAYER_BYTES;
                { SchedTiles S; S.so.init(MH, 7168, G, bid); S.A = (const char*)(a.ws + OFF_H); S.B = (const char*)(wl + WOFF_CAT); S.tA = (size_t)256 * 1024 * 2; S.tB = (size_t)256 * 1024 * 2;
                  EpiP1 E{a.ws, lds + 131072};
                  pg8::gemm_phase<EpiP1, SchedTiles, true>(lds, tid, 1024, 1024, 1024, S, E); }
                { SchedTiles S; S.so.init(MH, 4096, G, bid); S.A = (const char*)(a.ws + OFF_H8); S.B = (const char*)(wl + WOFF_G8); S.tA = (size_t)256 * 1024; S.tB = (size_t)256 * 1024;
                  EpiG E{(bf16_t*)(a.ws + OFF_G), a.in[I_BMG] + (size_t)l * 4096, (const unsigned*)(a.ws + OFF_AMAX) + l * 4096, (const float*)(a.ws + OFF_RS)};
                  pg8::gemm_phase<EpiG, SchedTiles, true, true>(lds, opaque_s(wave) * 64 + opaque_lane(), 512, 512, 512, S, E); }
            } else if (s == 2) {
                PHASE_ARGS; const bool xtra = (PROBE_REP >= 16 && PROBE_REP <= 18) && (p % PH_PER_PASS) == 3; const bool do_gl = !xtra || PROBE_REP == 16, do_ab = !xtra || PROBE_REP == 17, do_d = !xtra || PROBE_REP == 18;
                if (do_gl) for (int u = bid; u < BPH * 4 * moba::NGRP; u += G) { const int sq = u / moba::NGRP, g = u % moba::NGRP;
                    moba::gla_local((const bf16_t*)(a.ws + OFF_CQK), (const bf16_t*)(a.ws + OFF_CV), (const float*)(a.ws + OFF_LRF), a.in[I_CW2] + (size_t)l * 16 * 256, a.in[I_CB] + (size_t)l * 256, (bf16_t*)(a.ws + OFF_OL), (bf16_t*)(a.ws + OFF_QTO), (float*)(a.ws + OFF_BLO), (float*)(a.ws + OFF_TT), (float*)(a.ws + OFF_DGO), sq >> 2, sq & 3, g, (char*)lds_raw, opaque_s(wave) * 64 + opaque_lane()); }
                __syncthreads();
                if (!do_ab) {} else if (G >= 256) { if (bid < 128) moba::mixer_a_chunk((const bf16_t*)(a.ws + OFF_AV), (const bf16_t*)(a.ws + OFF_UZ), (bf16_t*)(a.ws + OFF_YA), (const bf16_t*)(a.ws + OFF_WA) + (size_t)l * 4 * 128 * 128, a.in[I_ALNG] + l * BW, a.in[I_ALNB] + l * BW, a.in[I_ASB] + l * 4 * 128, bid, (char*)lds_raw, opaque_s(wave) * 64 + opaque_lane()); else mixer_b_prep(a, l, bid - 128, lds, opaque_s(wave) * 64 + opaque_lane(), wave, opaque_lane()); }
                else { for (int c = bid; c < MH / 128; c += G) moba::mixer_a_chunk((const bf16_t*)(a.ws + OFF_AV), (const bf16_t*)(a.ws + OFF_UZ), (bf16_t*)(a.ws + OFF_YA), (const bf16_t*)(a.ws + OFF_WA) + (size_t)l * 4 * 128 * 128, a.in[I_ALNG] + l * BW, a.in[I_ALNB] + l * BW, a.in[I_ASB] + l * 4 * 128, c, (char*)lds_raw, opaque_s(wave) * 64 + opaque_lane()); for (int u = bid; u < BPH * 32; u += G) mixer_b_prep(a, l, u, lds, opaque_s(wave) * 64 + opaque_lane(), wave, opaque_lane()); }
                if (do_d) mixer_d_conv(a, l, opaque_s(wave) * 64 + opaque_lane());
            } else if (s == 3) {
                PHASE_ARGS; (void)tid; (void)lane;
                mixer_b_attn(a, (char*)lds_raw, wave, G, bid, l * NSPLIT + hf, l, OFF_CZ);
#if PROBE_REP == 13
            } else if (s == 13) {
                PHASE_ARGS; (void)lane; unsigned char* wl = a.ws + OFF_W + (size_t)l * W_LAYER_BYTES;
                SchedTiles S; S.so.init(MH, NCAT, G, bid); S.A = (const char*)(a.ws + OFF_H); S.B = (const char*)(wl + WOFF_CAT); S.tA = (size_t)256 * 1024 * 2; S.tB = (size_t)256 * 1024 * 2;
                EpiNull E;
                pg8::gemm_phase<EpiNull, SchedTiles, true>(lds, tid, 1024, 1024, 1024, S, E);
#endif
#if PROBE_REP == 12 || PROBE_REP == 14
            } else if (s == 12) {
                PHASE_ARGS; (void)tid; (void)lane;
                mixer_b_attn(a, (char*)lds_raw, wave, G, bid, 4 + l * NSPLIT + hf, l, OFF_DCX);
#endif
#if PROBE_REP == 10
            } else if (s == 10) {
                PHASE_ARGS; (void)wave; (void)lane;
                for (int u = bid; u < BPH * 4 * moba::NGRP; u += G) { const int sq = u / moba::NGRP, g = u % moba::NGRP;
                    moba::gla_local((const bf16_t*)(a.ws + OFF_CQK), (const bf16_t*)(a.ws + OFF_CV), (const float*)(a.ws + OFF_LRF), a.in[I_CW2] + (size_t)l * 16 * 256, a.in[I_CB] + (size_t)l * 256, (bf16_t*)(a.ws + OFF_OL), (bf16_t*)(a.ws + OFF_QTO), (float*)(a.ws + OFF_BLO), (float*)(a.ws + OFF_TT), (float*)(a.ws + OFF_DGO), sq >> 2, sq & 3, g, (char*)lds_raw, tid); }
#endif
#if PROBE_REP == 3
            } else if (s == 6) {
                PHASE_ARGS; (void)wave; (void)lane;
#endif
            } else if (s == 4) {
                PHASE_ARGS; (void)lane; unsigned char* wl = a.ws + OFF_W + (size_t)l * W_LAYER_BYTES;
                SchedP3 S; S.so.init(MH, 1024, G, bid); S.Y[0] = (const char*)(a.ws + OFF_YA); S.Y[1] = (const char*)(a.ws + OFF_YB); S.Y[2] = (const char*)(a.ws + OFF_CZ); S.Y[3] = (const char*)(a.ws + OFF_YD);
                S.Wbo = (const char*)(wl + WOFF_BO); S.tA = (size_t)256 * 512 * 2;
                EpiP3 E{(const bf16_t*)(a.ws + OFF_G), (bf16_t*)(a.ws + OFF_MERGED), a.ws + OFF_PB};
                pg8::gemm_phase<EpiP3, SchedP3, true>(lds, tid, 512, 512, 512, S, E);
            } else {
                PHASE_ARGS; (void)lane; unsigned char* wl = a.ws + OFF_W + (size_t)l * W_LAYER_BYTES;
                SchedTiles S; S.so.init(MH, 1024, G, bid); S.A = (const char*)(a.ws + OFF_MERGED); S.B = (const char*)(wl + WOFF_OUT); S.tA = (size_t)256 * 1024 * 2; S.tB = (size_t)256 * 1024 * 2;
                EpiP4 E{(l == 0 ? a.in[I_X] : a.out) + (size_t)hf * MH * DM, a.out + (size_t)hf * MH * DM};
                pg8::gemm_phase<EpiP4, SchedTiles, true>(lds, tid, 1024, 1024, 1024, S, E);
                if (MERGE_S0 && PROBE_REP != 0 && !(l == DEPTH - 1 && hf == NSPLIT - 1)) {
                    const int np = l * NSPLIT + hf + 1; __syncthreads();
                    phase_rmsnorm(a, np / NSPLIT, np % NSPLIT, lds, opaque_s(wave) * 64 + opaque_lane(), wave, opaque_lane()); }
            }
        }
        if (ph + 1 < ph_hi) { xcd_barrier(gbar); if (PROBE_REP == 20) { xcd_barrier(gbar); xcd_barrier(gbar); } }
        if (ph_hi < 0) cg::this_grid().sync();
    }
}

extern "C" void kernel_launch(void* const* d_in, const int* in_sizes, int n_in, void* d_out, int out_size, void* d_ws, size_t ws_size, hipStream_t stream) {
    static int grid = 0;
    if (grid == 0) {
        if (n_in != 18 || out_size != BATCH * SEQ * DM || ws_size < WS_END) { fprintf(stderr, "kernel_launch: unexpected shapes (n_in %d out %d ws %zu)\n", n_in, out_size, ws_size); grid = -1; return; }
        int dev = 0, cus = 0, per_cu = 0;
        (void)hipGetDevice(&dev); (void)hipDeviceGetAttribute(&cus, hipDeviceAttributeMultiprocessorCount, dev);
        (void)hipFuncSetAttribute((const void*)fwd_kernel, hipFuncAttributeMaxDynamicSharedMemorySize, LDS_BYTES);
        (void)hipOccupancyMaxActiveBlocksPerMultiprocessor(&per_cu, (const void*)fwd_kernel, NTHREADS, LDS_BYTES);
        if (per_cu < 1) { fprintf(stderr, "kernel_launch: occupancy query says %d blocks per CU\n", per_cu); per_cu = 1; }
        (void)hipGetLastError();
        grid = cus * 1;
    }
    if (grid < 0) return;
    Args a{};
    for (int i = 0; i < 18; ++i) a.in[i] = (const float*)d_in[i];
    a.out = (float*)d_out; a.ws = (unsigned char*)d_ws;
#if MK_N_LAUNCHES == 1
    (void)hipMemsetAsync((unsigned char*)d_ws + OFF_CTL, 0, CTL_BYTES, stream);
    a.ph_lo = 0; a.ph_hi = N_PHASES;
    void* args[] = {&a};
    hipError_t e = hipLaunchCooperativeKernel((const void*)fwd_kernel, dim3(grid), dim3(NTHREADS), args, LDS_BYTES, stream);
    if (e != hipSuccess) fprintf(stderr, "cooperative launch failed: %s (grid %d)\n", hipGetErrorString(e), grid);
#else
    for (int ph = 0; ph < N_PHASES; ++ph) {
        a.ph_lo = ph; a.ph_hi = ph + 1;
        hipLaunchKernelGGL(fwd_kernel, dim3(grid), dim3(NTHREADS), LDS_BYTES, stream, a);
    }
#endif
}
```

```cpp
#include <hip/hip_runtime.h>
#include <hip/hip_cooperative_groups.h>
#include <cstdio>
#include <cstdint>
namespace cg = cooperative_groups;

#ifndef MK_N_LAUNCHES
#define MK_N_LAUNCHES 1
#endif

#ifndef PROBE_REP
#define PROBE_REP -1
#endif
#ifndef MERGE_S0
#define MERGE_S0 1
#endif
#define LAS __attribute__((address_space(3)))
typedef unsigned short bf16_t;
typedef short bf16x8 __attribute__((ext_vector_type(8)));
typedef float f32x4 __attribute__((ext_vector_type(4)));
typedef float f32x2 __attribute__((ext_vector_type(2)));
typedef unsigned u32x4 __attribute__((ext_vector_type(4)));
typedef unsigned u32x2 __attribute__((ext_vector_type(2)));

constexpr int DM = 1024, BATCH = 8, SEQ = 4096, DEPTH = 2, BW = 512, NIN = 7184;
constexpr int NSPLIT = 2, BPH = BATCH / NSPLIT, MH = BPH * SEQ;
constexpr int NCAT = 11264, NT1 = NCAT / 256;
constexpr int A_OFF = 0, B_OFF = 1536, C_OFF = 3584, D_OFF = 5136;
constexpr float EPS = 1e-6f;
constexpr int NWAVES = 8, NTHREADS = 512;
constexpr int LDS_BYTES = 147456 + 64;

constexpr size_t MiB = 1u << 20;
constexpr size_t W_LAYER_BYTES = 30 * MiB;
constexpr size_t WOFF_CAT = 0, WOFF_BO = (size_t)NCAT * 1024 * 2, WOFF_OUT = WOFF_BO + (size_t)4096 * 512 * 2;
static_assert(WOFF_OUT + (size_t)1024 * 1024 * 2 <= W_LAYER_BYTES, "weights");
constexpr size_t OFF_W = 0;
constexpr size_t OFF_H = 60 * MiB;
constexpr size_t OFF_YA = OFF_H, OFF_YD = OFF_H + 16 * MiB, OFF_MERGED = 188 * MiB;
constexpr size_t OFF_UZ = 92 * MiB;
constexpr size_t OFF_AV = 108 * MiB;
constexpr size_t OFF_PB = 124 * MiB;
constexpr size_t OFF_CQK = 188 * MiB;
constexpr size_t OFF_CV = 204 * MiB;
constexpr size_t OFF_CZ = 220 * MiB;
constexpr size_t OFF_DCX = 244 * MiB;
constexpr size_t OFF_DBZ = 260 * MiB;
constexpr size_t OFF_YB = 276 * MiB;
constexpr size_t OFF_G = 292 * MiB;
constexpr size_t OFF_KMEAN = 436 * MiB;
constexpr size_t OFF_WA = 436 * MiB + 512 * 1024;
constexpr size_t OFF_OL = 440 * MiB;
constexpr size_t OFF_QTO = 456 * MiB;
constexpr size_t OFF_TT = 464 * MiB;
constexpr size_t OFF_BLO = 472 * MiB;
constexpr size_t OFF_LRF = 473 * MiB;
constexpr size_t OFF_WLR = 436 * MiB + 768 * 1024;
constexpr size_t OFF_DGO = 472 * MiB + 512 * 1024;
constexpr size_t OFF_ATTP = 474 * MiB;
constexpr size_t OFF_CTL = 500 * MiB;
constexpr size_t CTL_BYTES = 65536;
constexpr size_t OFF_AMAX = OFF_CTL + 32768;
constexpr size_t OFF_RS = OFF_CTL + 65536;
constexpr size_t OFF_H8 = 276 * MiB;
constexpr size_t WOFF_G8 = (size_t)7168 * 1024 * 2;
constexpr size_t WS_END = 501 * MiB;

__device__ __forceinline__ unsigned f2bf(float f) { unsigned u = __builtin_bit_cast(unsigned, f); return (u + 0x7fffu + ((u >> 16) & 1u)) >> 16; }
typedef __bf16 bf16x2_hw __attribute__((ext_vector_type(2)));
__device__ __forceinline__ unsigned pk2(float lo, float hi) { f32x2 v = {lo, hi}; bf16x2_hw b = __builtin_convertvector(v, bf16x2_hw); return __builtin_bit_cast(unsigned, b); }
__device__ __forceinline__ float bf_lo(unsigned w) { return __builtin_bit_cast(float, w << 16); }
__device__ __forceinline__ float bf_hi(unsigned w) { return __builtin_bit_cast(float, w & 0xffff0000u); }
__device__ __forceinline__ float bf2f(bf16_t b) { return __builtin_bit_cast(float, (unsigned)b << 16); }
__device__ __forceinline__ void unpack8(const u32x4 w, float (&f)[8]) { f[0] = bf_lo(w.x); f[1] = bf_hi(w.x); f[2] = bf_lo(w.y); f[3] = bf_hi(w.y); f[4] = bf_lo(w.z); f[5] = bf_hi(w.z); f[6] = bf_lo(w.w); f[7] = bf_hi(w.w); }
__device__ __forceinline__ u32x4 pack8(const float (&f)[8]) { u32x4 w; w.x = pk2(f[0], f[1]); w.y = pk2(f[2], f[3]); w.z = pk2(f[4], f[5]); w.w = pk2(f[6], f[7]); return w; }
__device__ __forceinline__ int opaque_lane() { int l; asm volatile("v_mbcnt_lo_u32_b32 %0, -1, 0\n\tv_mbcnt_hi_u32_b32 %0, -1, %0" : "=v"(l)); return l; }
__device__ __forceinline__ int opaque_s(int v) { asm volatile("" : "+s"(v)); return v; }
template <int CTRL> __device__ __forceinline__ float dpp_t(float v) { return __builtin_bit_cast(float, __builtin_amdgcn_update_dpp(0, __builtin_bit_cast(int, v), CTRL, 0xf, 0xf, true)); }
#define dpp_f(v, ctrl) dpp_t<ctrl>(v)
#define DPP_QX1 0xB1
#define DPP_QX2 0x4E
#define DPP_HMIR 0x141
#define DPP_RMIR 0x140
#define DPP_ROR8 0x128
__device__ __forceinline__ float swz_x4(float v) { return __builtin_bit_cast(float, __builtin_amdgcn_ds_swizzle(__builtin_bit_cast(int, v), (4 << 10) | 0x1f)); }
__device__ __forceinline__ float sum_x16(float v) { auto r = __builtin_amdgcn_permlane16_swap(__float_as_uint(v), __float_as_uint(v), false, false); return __uint_as_float(r[0]) + __uint_as_float(r[1]); }
__device__ __forceinline__ float sum_x32(float v) { auto r = __builtin_amdgcn_permlane32_swap(__float_as_uint(v), __float_as_uint(v), false, false); return __uint_as_float(r[0]) + __uint_as_float(r[1]); }
__device__ __forceinline__ float xchg16(float v, bool odd_row) { auto r = __builtin_amdgcn_permlane16_swap(__float_as_uint(v), __float_as_uint(v), false, false); return __uint_as_float(odd_row ? r[0] : r[1]); }
__device__ __forceinline__ float xchg32(float v, bool upper) { auto r = __builtin_amdgcn_permlane32_swap(__float_as_uint(v), __float_as_uint(v), false, false); return __uint_as_float(upper ? r[0] : r[1]); }
__device__ __forceinline__ float row16_sum(float v) { v += dpp_f(v, DPP_QX1); v += dpp_f(v, DPP_QX2); v += dpp_f(v, DPP_HMIR); v += dpp_f(v, DPP_RMIR); return v; }
__device__ __forceinline__ float wave_sum(float v) { return sum_x32(sum_x16(row16_sum(v))); }
__device__ __forceinline__ float wave_max(float v) { v = fmaxf(v, dpp_f(v, DPP_QX1)); v = fmaxf(v, dpp_f(v, DPP_QX2)); v = fmaxf(v, dpp_f(v, DPP_HMIR)); v = fmaxf(v, dpp_f(v, DPP_RMIR));
    { auto r = __builtin_amdgcn_permlane16_swap(__float_as_uint(v), __float_as_uint(v), false, false); v = fmaxf(__uint_as_float(r[0]), __uint_as_float(r[1])); }
    { auto r = __builtin_amdgcn_permlane32_swap(__float_as_uint(v), __float_as_uint(v), false, false); v = fmaxf(__uint_as_float(r[0]), __uint_as_float(r[1])); } return v; }
__device__ __forceinline__ unsigned pk4_fp8(float a, float b, float c, float d) { int w = __builtin_amdgcn_cvt_pk_fp8_f32(a, b, 0, false); w = __builtin_amdgcn_cvt_pk_fp8_f32(c, d, w, true); return (unsigned)w; }
__device__ __forceinline__ f32x2 exp2_2(f32x2 t) { f32x2 e; e.x = __builtin_amdgcn_exp2f(t.x); e.y = __builtin_amdgcn_exp2f(t.y); return e; }
__device__ __forceinline__ f32x2 rcp_2(f32x2 d) { f32x2 r; r.x = __builtin_amdgcn_rcpf(d.x); r.y = __builtin_amdgcn_rcpf(d.y); return r; }
__device__ __forceinline__ f32x2 exp2c_2(f32x2 t) { f32x2 e; e.x = __builtin_amdgcn_fmed3f(__builtin_amdgcn_exp2f(t.x), 0.f, 1.f); e.y = __builtin_amdgcn_fmed3f(__builtin_amdgcn_exp2f(t.y), 0.f, 1.f); return e; }
enum { ACT_NONE = 0, ACT_GELU = 1, ACT_SILU = 2, ACT_SIGM = 3 };
template <int ACT> __device__ __forceinline__ f32x2 den2(f32x2 x) {
    if (ACT == ACT_NONE) return (f32x2){1.f, 1.f};
    if (ACT == ACT_GELU) { const f32x2 x2 = x * x; const f32x2 a = x * (x2 * (-0.044715f * 1.5957691216057308f * 1.4426950408889634f) + (-1.5957691216057308f * 1.4426950408889634f)); return exp2_2(a) + 1.0f; }
    return exp2_2(x * (-1.4426950408889634f)) + 1.0f;
}
template <int ACT> __device__ __forceinline__ f32x2 num2(f32x2 x) { if (ACT == ACT_SIGM) return (f32x2){1.f, 1.f}; return x; }
template <int ACT> __device__ __forceinline__ f32x2 act2(f32x2 x) { if (ACT == ACT_NONE) return x; return num2<ACT>(x) * rcp_2(den2<ACT>(x)); }
template <int A0, int A1> __device__ __forceinline__ f32x2 act2_prod(f32x2 a, f32x2 b) {
    if (A0 == ACT_NONE && A1 == ACT_NONE) return a * b;
    if (A0 == ACT_NONE) return a * act2<A1>(b);
    if (A1 == ACT_NONE) return act2<A0>(a) * b;
    return (num2<A0>(a) * num2<A1>(b)) * rcp_2(den2<A0>(a) * den2<A1>(b));
}

namespace pg8 {
constexpr int BM = 256, BK = 64, HALF = 128, HTB = HALF * BK * 2, STAGE_BYTES = 8 * HTB, NXCD = 8, WGM = 4;
__device__ __forceinline__ int lds_byte(int r, int c) { const int st = (r >> 4) * 2 + (c >> 5), rr = r & 15, cc = c & 31, ob = rr * 64 + cc * 2; return st * 1024 + (ob ^ (((ob >> 9) & 1) << 5)); }
__device__ __forceinline__ void stage_rc(int b, int& R, int& C) { const int st = b / 1024, sb = b % 1024, swz = sb ^ (((sb >> 9) & 1) << 5); R = (st >> 1) * 16 + swz / 64; C = (st & 1) * 32 + (swz % 64) / 2; }
__device__ __forceinline__ int perm32(int rho) { const int n = rho >> 4, i = rho & 15; return 8 * (i >> 2) + 4 * n + (i & 3); }

struct Unit { int pm, pn; };
struct GUnit { int pm, pn, br; const char* A; const char* B; };
struct StaticOrder {
    int nM, nN, nwg, G, c;
    __device__ void init(int M, int N, int G_, int c_) { nM = M / BM; nN = N / BM; nwg = nM * nN; G = G_; c = c_; }
    __device__ bool next(int i, Unit& u) const {
        const long L = (long)i * G + c; if (L >= nwg) return false;
        int wgid = (int)L; { const int q = nwg / NXCD, r = nwg % NXCD, xcd = wgid % NXCD, off = wgid / NXCD; wgid = (xcd < r ? xcd * (q + 1) : r * (q + 1) + (xcd - r) * q) + off; }
        const int nig = WGM * nN, gid = wgid / nig, fm = gid * WGM, gsz = (nM - fm) < WGM ? (nM - fm) : WGM;
        u.pm = fm + ((wgid % nig) % gsz); u.pn = (wgid % nig) / gsz; return true;
    }
};

typedef int i32x4v __attribute__((ext_vector_type(4)));
typedef int i32x8v __attribute__((ext_vector_type(8)));
__device__ __forceinline__ i32x8v cat8(bf16x8 a, bf16x8 b) { return __builtin_shufflevector(__builtin_bit_cast(i32x4v, a), __builtin_bit_cast(i32x4v, b), 0, 1, 2, 3, 4, 5, 6, 7); }
template <class Epi, class Sched, bool ALIGN_EPI, bool FP8 = false>
__device__ __forceinline__ void gemm_phase(LAS unsigned char* lds, const int tid, const int K, const int lda, const int ldb, const Sched& S, const Epi& E) {
    const int wid = __builtin_amdgcn_readfirstlane(tid >> 6), lane = tid & 63, wr = wid >> 2, wc = wid & 3, fr = lane & 15, fq = lane >> 4;
    const int nt = K / BK;
    unsigned voffA[2], voffB[2];
#pragma unroll
    for (int i = 0; i < 2; ++i) { int R, C; stage_rc(tid * 16 + i * 8192, R, C); const int Rb = Epi::PERM ? ((R & ~31) + perm32(R & 31)) : R;
        voffA[i] = (unsigned)(R * lda + C) * 2u; voffB[i] = (unsigned)(Rb * ldb + C) * 2u; }
    const size_t kstep = (size_t)(BK * 2);
    const size_t hA = (size_t)HALF * lda * 2, hB = (size_t)HALF * ldb * 2;
    const unsigned ldsw = (unsigned)wid * 1024u;
    const int aoff = lds_byte(wr * 64 + fr, fq * 8), boff = lds_byte(wc * 32 + fr, fq * 8);
#define PG8_SA(b, h) (((b) * 2 + (h)) * HTB)
#define PG8_SB(b, h) ((4 + (b) * 2 + (h)) * HTB)
#define PG8_STAGE(bufoff, gbase, voff) do { _Pragma("unroll") for (int _i = 0; _i < 2; ++_i) { unsigned vo_ = (voff)[_i]; asm volatile("" : "+v"(vo_));   \
        __builtin_amdgcn_global_load_lds((const unsigned*)((const char*)(gbase) + vo_), (LAS unsigned*)(lds + (bufoff) + ldsw + _i * 8192), 16, 0, 0); } } while (0)
#define PG8_LDA(dst, b, h) do { _Pragma("unroll") for (int m = 0; m < 4; ++m) { const bf16x8 x0_ = *(const LAS bf16x8*)(lds + PG8_SA(b, h) + aoff + m * 2048), x1_ = *(const LAS bf16x8*)(lds + PG8_SA(b, h) + aoff + m * 2048 + 1024); \
        if constexpr (FP8) dst##8[m] = cat8(x0_, x1_); else { dst[m][0] = x0_; dst[m][1] = x1_; } } } while (0)
#define PG8_LDB(dst, b, h) do { _Pragma("unroll") for (int n = 0; n < 2; ++n) { const bf16x8 x0_ = *(const LAS bf16x8*)(lds + PG8_SB(b, h) + boff + n * 2048), x1_ = *(const LAS bf16x8*)(lds + PG8_SB(b, h) + boff + n * 2048 + 1024); \
        if constexpr (FP8) dst##8[n] = cat8(x0_, x1_); else { dst[n][0] = x0_; dst[n][1] = x1_; } } } while (0)
#define PG8_MMA(ai, bj, At, Bt) do { __builtin_amdgcn_s_setprio(1); _Pragma("unroll") for (int m = 0; m < 4; ++m) _Pragma("unroll") for (int n = 0; n < 2; ++n) { \
        if constexpr (FP8) acc[ai][bj][m][n] = __builtin_amdgcn_mfma_scale_f32_16x16x128_f8f6f4(Bt##8[n], At##8[m], acc[ai][bj][m][n], 0, 0, 0, 0, 0, 0); \
        else { _Pragma("unroll") for (int k = 0; k < 2; ++k) acc[ai][bj][m][n] = __builtin_amdgcn_mfma_f32_16x16x32_bf16(Bt[n][k], At[m][k], acc[ai][bj][m][n], 0, 0, 0); } } \
        __builtin_amdgcn_s_setprio(0); } while (0)
#define PG8_WAIT_V(n) asm volatile("s_waitcnt vmcnt(" #n ")" ::: "memory")
#define PG8_WAIT_L(n) asm volatile("s_waitcnt lgkmcnt(" #n ")" ::: "memory")
#define PG8_BAR __builtin_amdgcn_s_barrier()
#define PG8_SCHED __builtin_amdgcn_sched_barrier(0)
    GUnit cur, nxt; int ui = 0;
    if (!S.next(0, cur)) return;
    f32x4 acc[2][2][4][2];
#pragma unroll
    for (int a = 0; a < 2; ++a)
#pragma unroll
        for (int b = 0; b < 2; ++b)
#pragma unroll
            for (int m = 0; m < 4; ++m)
#pragma unroll
                for (int n = 0; n < 2; ++n) acc[a][b][m][n] = (f32x4){0.f, 0.f, 0.f, 0.f};
    if constexpr (Epi::INIT) E.init(acc, cur, wr, wc, fr, fq);
    bf16x8 At[4][2], B0[2][2], B1[2][2]; i32x8v At8[4], B08[2], B18[2];
    const char* cA = cur.A; const char* cB = cur.B;
    PG8_STAGE(PG8_SB(0, 0), cB, voffB); PG8_STAGE(PG8_SB(0, 1), cB + hB, voffB); PG8_STAGE(PG8_SA(0, 0), cA, voffA); PG8_STAGE(PG8_SA(0, 1), cA + hA, voffA);
    if (wr == 1) PG8_BAR;
    PG8_WAIT_V(2); PG8_BAR;
    PG8_STAGE(PG8_SB(1, 0), cB + kstep, voffB); PG8_STAGE(PG8_SA(1, 0), cA + kstep, voffA); PG8_STAGE(PG8_SB(1, 1), cB + hB + kstep, voffB);
    PG8_WAIT_V(6); PG8_BAR;
    for (;;) {
        const bool has_next = S.next(ui + 1, nxt);
        const char* nA = has_next ? nxt.A : cA; const char* nB = has_next ? nxt.B : cB;
#pragma unroll 1
        for (int t = 0; t < nt; t += 2) {
            const bool last = (t == nt - 2);
            const char* a1 = cA + (size_t)(t + 1) * kstep;
            const char* a2 = last ? nA : cA + (size_t)(t + 2) * kstep; const char* b2 = last ? nB : cB + (size_t)(t + 2) * kstep;
            const char* a3 = a2 + kstep; const char* b3 = b2 + kstep;
            PG8_LDB(B0, 0, 0); PG8_LDB(B1, 0, 1); PG8_SCHED; PG8_LDA(At, 0, 0); PG8_STAGE(PG8_SA(1, 1), a1 + hA, voffA);
            PG8_WAIT_V(8); PG8_WAIT_L(0); PG8_BAR; PG8_MMA(0, 0, At, B0); PG8_MMA(0, 1, At, B1); PG8_BAR; PG8_SCHED;
            PG8_LDA(At, 0, 1); PG8_STAGE(PG8_SB(0, 0), b2, voffB); PG8_STAGE(PG8_SB(0, 1), b2 + hB, voffB); PG8_STAGE(PG8_SA(0, 0), a2, voffA);
            PG8_WAIT_V(8); PG8_WAIT_L(0); PG8_BAR; PG8_MMA(1, 0, At, B0); PG8_MMA(1, 1, At, B1); PG8_BAR; PG8_SCHED;
            PG8_LDB(B0, 1, 0); PG8_LDB(B1, 1, 1); PG8_SCHED; PG8_LDA(At, 1, 0); PG8_STAGE(PG8_SA(0, 1), a2 + hA, voffA);
            PG8_WAIT_V(8); PG8_WAIT_L(0); PG8_BAR; PG8_MMA(0, 0, At, B0); PG8_MMA(0, 1, At, B1); PG8_BAR; PG8_SCHED;
            PG8_LDA(At, 1, 1); PG8_STAGE(PG8_SB(1, 0), b3, voffB); PG8_STAGE(PG8_SB(1, 1), b3 + hB, voffB); PG8_STAGE(PG8_SA(1, 0), a3, voffA);
            PG8_WAIT_V(8); PG8_WAIT_L(0); PG8_BAR; PG8_MMA(1, 0, At, B0); PG8_MMA(1, 1, At, B1); PG8_BAR; PG8_SCHED;
        }
        if constexpr (ALIGN_EPI) { if (wr == 0) PG8_BAR; }
        E(acc, cur, wr, wc, fr, fq);
        if (PROBE_REP == 21) E(acc, cur, wr, wc, fr, fq);
        if (!has_next) break;
        if (!Epi::CHAIN || cur.br == 3) {
#pragma unroll
        for (int a = 0; a < 2; ++a)
#pragma unroll
            for (int b = 0; b < 2; ++b)
#pragma unroll
                for (int m = 0; m < 4; ++m)
#pragma unroll
                    for (int n = 0; n < 2; ++n) acc[a][b][m][n] = (f32x4){0.f, 0.f, 0.f, 0.f};
        }
        if constexpr (Epi::INIT) { E.init(acc, nxt, wr, wc, fr, fq); asm volatile("s_waitcnt vmcnt(0)" ::: "memory"); }
        cur = nxt; cA = nA; cB = nB; ++ui;
        if constexpr (ALIGN_EPI) { if (wr == 1) PG8_BAR; }
    }
    PG8_WAIT_V(0);
    if constexpr (!ALIGN_EPI) { if (wr == 0) PG8_BAR; }
    PG8_BAR;
#undef PG8_SA
#undef PG8_SB
#undef PG8_STAGE
#undef PG8_LDA
#undef PG8_LDB
#undef PG8_MMA
#undef PG8_WAIT_V
#undef PG8_WAIT_L
#undef PG8_BAR
#undef PG8_SCHED
}
}

typedef const f32x4 (&AccRef)[2][2][4][2];

struct LPerm { LAS unsigned char* sc; unsigned wpos, rpos; int lr, lp; };
__device__ __forceinline__ LPerm lperm_init(LAS unsigned char* scr, int wid) {
    const int ln = opaque_lane(), fr = ln & 15, fq = ln >> 4, pw = 4 * fr + fq;
    LPerm P; P.sc = scr + wid * 2048; P.wpos = 16u * (unsigned)(pw ^ ((pw >> 3) & 3)); P.rpos = 16u * (unsigned)(ln ^ ((ln >> 3) & 3)); P.lr = ln >> 2; P.lp = ln & 3; return P;
}
__device__ __forceinline__ u32x4 lperm_rows(const LPerm& P, int slot, u32x4 w) { LAS unsigned char* s_ = P.sc + slot * 1024; *(LAS u32x4*)(s_ + P.wpos) = w; const u32x4 t_ = *(const LAS u32x4*)(s_ + P.rpos); __builtin_amdgcn_sched_barrier(0); return t_; }

template <int ACT, bool HASBIAS>
__device__ __forceinline__ void epi_plain(AccRef acc, const pg8::GUnit& u, int wr, int wc, LAS unsigned char* scr, bf16_t* base, int ldc, int col, const float* bias) {
    const LPerm P = lperm_init(scr, wr * 4 + wc);
    bf16_t* ob = base + (size_t)(u.pm * 256 + wr * 64 + P.lr) * ldc + col + wc * 32 + 8 * P.lp;
    f32x4 bv[2][2];
#pragma unroll
    for (int bj = 0; bj < 2; ++bj)
#pragma unroll
        for (int n = 0; n < 2; ++n) bv[bj][n] = HASBIAS ? *(const f32x4*)(bias + bj * 128 + wc * 32 + 8 * (opaque_lane() >> 4) + 4 * n) : (f32x4){0.f, 0.f, 0.f, 0.f};
    u32x4 pend; bf16_t* pdst = ob;
#pragma unroll
    for (int ai = 0; ai < 2; ++ai)
#pragma unroll
        for (int m = 0; m < 4; ++m) {
#pragma unroll
            for (int bj = 0; bj < 2; ++bj) { const f32x4 v0 = acc[ai][bj][m][0] + bv[bj][0], v1 = acc[ai][bj][m][1] + bv[bj][1];
                const f32x2 r0 = act2<ACT>((f32x2){v0[0], v0[1]}), r1 = act2<ACT>((f32x2){v0[2], v0[3]}), r2 = act2<ACT>((f32x2){v1[0], v1[1]}), r3 = act2<ACT>((f32x2){v1[2], v1[3]});
                u32x4 w; w.x = pk2(r0.x, r0.y); w.y = pk2(r1.x, r1.y); w.z = pk2(r2.x, r2.y); w.w = pk2(r3.x, r3.y);
                if (ai + m + bj > 0) __builtin_nontemporal_store(pend, (u32x4*)pdst);
                pend = lperm_rows(P, bj, w); pdst = ob + (size_t)(ai * 128 + m * 16) * ldc + bj * 128; } }
    __builtin_nontemporal_store(pend, (u32x4*)pdst);
}
template <int A0, int A1>
__device__ __forceinline__ void epi_pair(AccRef acc, const pg8::GUnit& u, int wr, int wc, LAS unsigned char* scr, bf16_t* base, int ldc, int col) {
    const LPerm P = lperm_init(scr, wr * 4 + wc);
    bf16_t* ob = base + (size_t)(u.pm * 256 + wr * 64 + P.lr) * ldc + col + wc * 32 + 8 * P.lp;
    u32x4 pend; bf16_t* pdst = ob;
#pragma unroll
    for (int ai = 0; ai < 2; ++ai)
#pragma unroll
        for (int m = 0; m < 4; ++m) {
            const f32x4 a0 = acc[ai][0][m][0], a1 = acc[ai][0][m][1], b0 = acc[ai][1][m][0], b1 = acc[ai][1][m][1];
            const f32x2 r0 = act2_prod<A0, A1>((f32x2){a0[0], a0[1]}, (f32x2){b0[0], b0[1]}), r1 = act2_prod<A0, A1>((f32x2){a0[2], a0[3]}, (f32x2){b0[2], b0[3]});
            const f32x2 r2 = act2_prod<A0, A1>((f32x2){a1[0], a1[1]}, (f32x2){b1[0], b1[1]}), r3 = act2_prod<A0, A1>((f32x2){a1[2], a1[3]}, (f32x2){b1[2], b1[3]});
            u32x4 w; w.x = pk2(r0.x, r0.y); w.y = pk2(r1.x, r1.y); w.z = pk2(r2.x, r2.y); w.w = pk2(r3.x, r3.y);
            if (ai + m > 0) __builtin_nontemporal_store(pend, (u32x4*)pdst);
            pend = lperm_rows(P, m & 1, w); pdst = ob + (size_t)(ai * 128 + m * 16) * ldc; }
    __builtin_nontemporal_store(pend, (u32x4*)pdst);
}
struct EpiP1 {
    static constexpr bool PERM = true, CHAIN = false, INIT = false;
    unsigned char* ws; LAS unsigned char* scr;
    __device__ __forceinline__ void operator()(AccRef acc, const pg8::GUnit& u, int wr, int wc, int, int) const {
        const int pn = u.pn;
        if (pn < 4) epi_pair<ACT_GELU, ACT_SILU>(acc, u, wr, wc, scr, (bf16_t*)(ws + OFF_UZ), 512, 128 * pn);
        else if (pn < 6) epi_plain<ACT_GELU, false>(acc, u, wr, wc, scr, (bf16_t*)(ws + OFF_AV), 512, 256 * (pn - 4), nullptr);
        else if (pn < 12) epi_plain<ACT_NONE, false>(acc, u, wr, wc, scr, (bf16_t*)(ws + OFF_PB), 2048, 256 * (pn - 6), nullptr);
        else if (pn < 14) epi_plain<ACT_SILU, false>(acc, u, wr, wc, scr, (bf16_t*)(ws + OFF_PB), 2048, 256 * (pn - 6), nullptr);
        else if (pn < 16) epi_plain<ACT_NONE, false>(acc, u, wr, wc, scr, (bf16_t*)(ws + OFF_CQK), 512, 256 * (pn - 14), nullptr);
        else if (pn < 18) epi_plain<ACT_NONE, false>(acc, u, wr, wc, scr, (bf16_t*)(ws + OFF_CV), 512, 256 * (pn - 16), nullptr);
        else if (pn < 20) epi_plain<ACT_SILU, false>(acc, u, wr, wc, scr, (bf16_t*)(ws + OFF_CZ), 512, 256 * (pn - 18), nullptr);
        else if (pn < 24) epi_pair<ACT_NONE, ACT_NONE>(acc, u, wr, wc, scr, (bf16_t*)(ws + OFF_DCX), 512, 128 * (pn - 20));
        else epi_pair<ACT_NONE, ACT_SILU>(acc, u, wr, wc, scr, (bf16_t*)(ws + OFF_DBZ), 512, 128 * (pn - 24));
    }
};
struct EpiG {
    static constexpr bool PERM = true, CHAIN = false, INIT = false;
    bf16_t* G; const float* bmg; const unsigned* amax; const float* rs;
    __device__ __forceinline__ void operator()(AccRef acc, const pg8::GUnit& u, int wr, int wc, int, int) const {
        const int ln = opaque_lane(), fr = ln & 15, fq = ln >> 4;
        const int row0 = u.pm * 256 + wr * 64 + fr, c0 = u.pn * 256 + wc * 32 + 8 * fq;
        char* gbu = (char*)G + ((size_t)((u.pm * 16 + u.pn) * 8 + wr * 4 + wc) << 13); const unsigned lo = (unsigned)ln * 8u;
        float rv[2][4];
#pragma unroll
        for (int ai = 0; ai < 2; ++ai)
#pragma unroll
            for (int m = 0; m < 4; ++m) rv[ai][m] = rs[row0 + ai * 128 + m * 16];
        f32x4 bv[2][2], cs[2][2];
#pragma unroll
        for (int bj = 0; bj < 2; ++bj)
#pragma unroll
            for (int n = 0; n < 2; ++n) { bv[bj][n] = *(const f32x4*)(bmg + c0 + bj * 128 + 4 * n); const u32x4 am = *(const u32x4*)(amax + c0 + bj * 128 + 4 * n);
                cs[bj][n] = (f32x4){__uint_as_float(am.x), __uint_as_float(am.y), __uint_as_float(am.z), __uint_as_float(am.w)} * (-1.4426950408889634f / 256.0f);
                bv[bj][n] = bv[bj][n] * -1.4426950408889634f - 8.988684686772166f; }
#pragma unroll
        for (int ai = 0; ai < 2; ++ai)
#pragma unroll
            for (int m = 0; m < 4; ++m) { const float r_ = rv[ai][m];
#pragma unroll
                for (int bj = 0; bj < 2; ++bj) { const f32x4 v0 = (acc[ai][bj][m][0] * r_) * cs[bj][0] + bv[bj][0], v1 = (acc[ai][bj][m][1] * r_) * cs[bj][1] + bv[bj][1];
                    const f32x2 r0 = rcp_2(exp2c_2((f32x2){v0[0], v0[1]}) + (1.0f / 508.0f)), r1 = rcp_2(exp2c_2((f32x2){v0[2], v0[3]}) + (1.0f / 508.0f));
                    const f32x2 r2 = rcp_2(exp2c_2((f32x2){v1[0], v1[1]}) + (1.0f / 508.0f)), r3 = rcp_2(exp2c_2((f32x2){v1[2], v1[3]}) + (1.0f / 508.0f));
                    const f32x2 t0 = r0 * (255.0f / 508.0f) + 8388608.0f, t1 = r1 * (255.0f / 508.0f) + 8388608.0f, t2 = r2 * (255.0f / 508.0f) + 8388608.0f, t3 = r3 * (255.0f / 508.0f) + 8388608.0f;
                    u32x2 w;
                    w.x = __builtin_amdgcn_perm(__builtin_amdgcn_perm(__float_as_uint(t1.y), __float_as_uint(t1.x), 0x0c0c0400u), __builtin_amdgcn_perm(__float_as_uint(t0.y), __float_as_uint(t0.x), 0x0c0c0400u), 0x05040100u);
                    w.y = __builtin_amdgcn_perm(__builtin_amdgcn_perm(__float_as_uint(t3.y), __float_as_uint(t3.x), 0x0c0c0400u), __builtin_amdgcn_perm(__float_as_uint(t2.y), __float_as_uint(t2.x), 0x0c0c0400u), 0x05040100u);
                    __builtin_nontemporal_store(w, (u32x2*)(gbu + (lo + (unsigned)(((ai * 4 + m) * 2 + bj) * 512)))); } }
    }
};
struct EpiNull {
    static constexpr bool PERM = true, CHAIN = false, INIT = false;
    __device__ __forceinline__ void operator()(AccRef acc, const pg8::GUnit&, int, int, int, int) const {
#pragma unroll
        for (int ai = 0; ai < 2; ++ai)
#pragma unroll
            for (int bj = 0; bj < 2; ++bj)
                asm volatile("" :: "v"(acc[ai][bj][0][0]), "v"(acc[ai][bj][0][1]), "v"(acc[ai][bj][1][0]), "v"(acc[ai][bj][1][1]), "v"(acc[ai][bj][2][0]), "v"(acc[ai][bj][2][1]), "v"(acc[ai][bj][3][0]), "v"(acc[ai][bj][3][1]));
    }
};
struct EpiP3 {
    static constexpr bool PERM = true, CHAIN = true, INIT = false;
    const bf16_t* G; bf16_t* merged;
    __device__ __forceinline__ void operator()(f32x4 (&acc)[2][2][4][2], const pg8::GUnit& u, int wr, int wc, int, int) const {
        const int ln = opaque_lane(); const int br = u.br;
        const char* gb = (const char*)G + ((size_t)((u.pm * 16 + br * 4 + u.pn) * 8 + wr * 4 + wc) << 13); const unsigned lo = (unsigned)ln * 8u;
        const char* gn = gb + ((size_t)(4 * 8) << 13);
        u32x2 gw[16], nw[16];
#pragma unroll
        for (int k = 0; k < 16; ++k) { const unsigned q = lo + (unsigned)(k * 512);
            gw[k] = __builtin_nontemporal_load((const u32x2*)(gb + q));
            if (br < 3) nw[k] = *(const u32x2*)(gn + q); }
#pragma unroll
        for (int k = 0; k < 16; ++k) { const int ai = k >> 3, m = (k >> 1) & 3, bj = k & 1;
            const unsigned gx = gw[k].x, gy = gw[k].y;
            float g[8] = {(float)(gx & 0xffu), (float)((gx >> 8) & 0xffu), (float)((gx >> 16) & 0xffu), (float)(gx >> 24),
                          (float)(gy & 0xffu), (float)((gy >> 8) & 0xffu), (float)((gy >> 16) & 0xffu), (float)(gy >> 24)};
            if (br < 3) { const unsigned hx = nw[k].x, hy = nw[k].y;
                const float h[8] = {(float)(hx & 0xffu), (float)((hx >> 8) & 0xffu), (float)((hx >> 16) & 0xffu), (float)(hx >> 24),
                                    (float)(hy & 0xffu), (float)((hy >> 8) & 0xffu), (float)((hy >> 16) & 0xffu), (float)(hy >> 24)};
#pragma unroll
                for (int q = 0; q < 8; q += 4) { const float p01 = h[q] * h[q + 1], p23 = h[q + 2] * h[q + 3], r = __builtin_amdgcn_rcpf(p01 * p23), r01 = r * p23, r23 = r * p01;
                    g[q] *= r01 * h[q + 1]; g[q + 1] *= r01 * h[q]; g[q + 2] *= r23 * h[q + 3]; g[q + 3] *= r23 * h[q + 2]; } }
            const f32x4 v0 = acc[ai][bj][m][0], v1 = acc[ai][bj][m][1];
            const f32x4 w0 = {v0[0] * g[0], v0[1] * g[1], v0[2] * g[2], v0[3] * g[3]}, w1 = {v1[0] * g[4], v1[1] * g[5], v1[2] * g[6], v1[3] * g[7]};
            if (br < 3) { acc[ai][bj][m][0] = w0; acc[ai][bj][m][1] = w1; }
            else { const int fr = ln & 15, fq = ln >> 4; const float f[8] = {w0[0], w0[1], w0[2], w0[3], w1[0], w1[1], w1[2], w1[3]};
                *(u32x4*)(merged + (size_t)(u.pm * 256 + wr * 64 + fr + ai * 128 + m * 16) * 1024 + u.pn * 256 + wc * 32 + 8 * fq + bj * 128) = pack8(f); } }
    }
};
struct EpiP4 {
    static constexpr bool PERM = false, CHAIN = false, INIT = true;
    const float* xin; float* out; LAS unsigned char* scr;
    __device__ __forceinline__ void init(f32x4 (&acc)[2][2][4][2], const pg8::GUnit& u, int wr, int wc, int fr, int fq) const {
        const unsigned o0 = (unsigned)((u.pm * 256 + wr * 64 + fr) * 1024 + u.pn * 256 + wc * 32 + 4 * fq);
#pragma unroll
        for (int ai = 0; ai < 2; ++ai)
#pragma unroll
            for (int m = 0; m < 4; ++m)
#pragma unroll
                for (int bj = 0; bj < 2; ++bj)
#pragma unroll
                    for (int n = 0; n < 2; ++n) acc[ai][bj][m][n] = __builtin_nontemporal_load((const f32x4*)(xin + (o0 + (unsigned)((ai * 128 + m * 16) * 1024 + bj * 128 + n * 16))));
    }
    __device__ __forceinline__ void operator()(AccRef acc, const pg8::GUnit& u, int wr, int wc, int, int) const {
        const int ln = opaque_lane(), fr = ln & 15, fq = ln >> 4;
        const unsigned o0 = (unsigned)((u.pm * 256 + wr * 64 + fr) * 1024 + u.pn * 256 + wc * 32 + 4 * fq);
#pragma unroll
        for (int ai = 0; ai < 2; ++ai)
#pragma unroll
            for (int m = 0; m < 4; ++m)
#pragma unroll
                for (int bj = 0; bj < 2; ++bj)
#pragma unroll
                    for (int n = 0; n < 2; ++n) *(f32x4*)(out + (o0 + (unsigned)((ai * 128 + m * 16) * 1024 + bj * 128 + n * 16))) = acc[ai][bj][m][n];
    }
};
struct SchedTiles {
    pg8::StaticOrder so; const char* A; const char* B; size_t tA, tB;
    __device__ __forceinline__ bool next(int i, pg8::GUnit& u) const { pg8::Unit t; if (!so.next(i, t)) return false; u.pm = t.pm; u.pn = t.pn; u.br = 0; u.A = A + (size_t)t.pm * tA; u.B = B + (size_t)t.pn * tB; return true; }
};
struct SchedP3 {
    pg8::StaticOrder so; const char* Y[4]; const char* Wbo; size_t tA;
    __device__ __forceinline__ bool next(int i, pg8::GUnit& u) const { pg8::Unit t; if (!so.next(i >> 2, t)) return false; const int br = i & 3; u.pm = t.pm; u.pn = t.pn; u.br = br;
        const char* y = br == 0 ? Y[0] : br == 1 ? Y[1] : br == 2 ? Y[2] : Y[3];
        u.A = y + (size_t)t.pm * tA; u.B = Wbo + ((size_t)br * 1024 + (size_t)t.pn * 256) * 512 * 2; return true; }
};

namespace moba {
constexpr int D = 128, NW = 8, QBLK = 32, KVBLK = 64, QB = NW * QBLK, LDQ = 2048, LDO = 512;
constexpr int SHM_V = KVBLK * D * 2, SHM_K = KVBLK * D * 2;
constexpr int NB = 3;
constexpr int OFF_STG = NB * SHM_V + NB * SHM_K, OFF_WS = OFF_STG + 32768, LDS_NEED = OFF_WS + NW * 64 * 4 + 64, OFF_KMT = LDS_NEED, KMT_LD = 132;
static_assert(OFF_KMT % 16 == 0 && OFF_KMT + 16 * KMT_LD * 4 <= 147456, "mean-key table");
constexpr float SCALE = 0.08838834764831845f, THR = 8.f;
typedef short s16x4 __attribute__((ext_vector_type(4)));
typedef float f32x16 __attribute__((ext_vector_type(16)));
#define KSWZ(row, colB) ((row) * 256 + ((colB) ^ (((row) & 7) << 4)))
#define SBAR() __builtin_amdgcn_sched_barrier(0)
__device__ __forceinline__ int v_st(int k, int c) { const int kk = (k & ~0xC) | ((k & 4) << 1) | ((k & 8) >> 1); return ((kk >> 3) * 4 + (c >> 5)) * 512 + ((kk & 7) * 32 + (c & 31)) * 2; }
__device__ __forceinline__ int v_rd_base(int lane) { return ((lane & 3) << 3) | (((lane >> 2) & 3) << 6) | (((lane >> 4) & 1) << 5) | (((lane >> 5) & 1) << 8); }
constexpr int v_rd_off(int d0, int ks, int half) { return d0 * 512 + ks * 4096 + half * 2048; }
__device__ __forceinline__ int crow(int r, int hi) { return (r & 3) + 8 * (r >> 2) + 4 * hi; }
__device__ __forceinline__ unsigned cvtpk(float lo, float hi) { unsigned r; asm volatile("v_cvt_pk_bf16_f32 %0, %1, %2" : "=v"(r) : "v"(lo), "v"(hi)); return r; }
__device__ __forceinline__ bf16x8 load8(const bf16_t* p) { return *reinterpret_cast<const bf16x8*>(p); }
typedef __bf16 bf16x2_t __attribute__((ext_vector_type(2)));
__device__ __forceinline__ unsigned cvtpk_s(float lo, float hi) { f32x2 v = {lo, hi}; bf16x2_t b = __builtin_convertvector(v, bf16x2_t); return __builtin_bit_cast(unsigned, b); }

__device__ __forceinline__ float fma_1(float a, float b, float c) { float d; asm("v_fma_f32 %0, %1, %2, %3" : "=v"(d) : "v"(a), "v"(b), "v"(c)); return d; }
__device__ __forceinline__ void mask_causal(f32x16& p0, f32x16& p1, int dq) {
    const float NEG = -__builtin_inff();
#pragma unroll
    for (int r = 0; r < 16; ++r) { const int c = (r & 3) + 8 * (r >> 2); if (dq - c < 0) p0[r] = NEG; if (dq - c - 32 < 0) p1[r] = NEG; }
}
template <int R> __device__ __forceinline__ float alibi_1(float sl, float pv) { constexpr int CB = __builtin_bit_cast(int, (float)((R & 3) + 8 * (R >> 2))); float d;
    asm("v_fmamk_f32 %0, %1, %2, %3" : "=v"(d) : "v"(sl), "n"(CB), "v"(pv)); return d; }
__device__ __forceinline__ void alibi_add(f32x16& p0, f32x16& p1, float slopeR) {
#define AL1(R) p0[R] = alibi_1<R>(slopeR, p0[R]); p1[R] = alibi_1<R>(slopeR, p1[R]);
    AL1(1) AL1(2) AL1(3) AL1(4) AL1(5) AL1(6) AL1(7) AL1(8) AL1(9) AL1(10) AL1(11) AL1(12) AL1(13) AL1(14) AL1(15)
#undef AL1
}
__device__ __forceinline__ void partialSM(f32x16& p0, f32x16& p1, float& m_reg, float& mn, float& alpha, float tb0, float tb1, bool keep) {
    float pm0 = p0[0], pm1 = p1[0];
#pragma unroll
    for (int r = 1; r < 16; ++r) { pm0 = fmaxf(pm0, p0[r]); pm1 = fmaxf(pm1, p1[r]); }
    tb0 = keep ? tb0 : -__builtin_inff(); tb1 = keep ? tb1 : -__builtin_inff();
    float pmax = fmaxf(pm0 + tb0, pm1 + tb1);
    { auto rr = __builtin_amdgcn_permlane32_swap(__float_as_uint(pmax), __float_as_uint(pmax), false, false);
      pmax = fmaxf(__uint_as_float(rr[0]), __uint_as_float(rr[1])); }
    constexpr float C2 = 1.4426950408889634f * SCALE;
    if (__builtin_expect(__all((pmax - m_reg) * SCALE <= THR), 1)) { mn = m_reg; alpha = 1.f; }
    else { mn = fmaxf(m_reg, pmax); alpha = __builtin_amdgcn_exp2f((m_reg - mn) * C2); m_reg = mn; }
    const float mnL0 = (tb0 - mn) * C2, mnL1 = (tb1 - mn) * C2;
#pragma unroll
    for (int r = 0; r < 16; ++r) p0[r] = fma_1(p0[r], C2, mnL0);
#pragma unroll
    for (int r = 0; r < 16; ++r) p1[r] = fma_1(p1[r], C2, mnL1);
#pragma unroll
    for (int r = 0; r < 16; ++r) p0[r] = __builtin_amdgcn_exp2f(p0[r]);
}
__device__ __forceinline__ void finishSM(f32x16& p0, f32x16& p1, float alpha, float& l_reg, bf16x8& pa0, bf16x8& pa1, bf16x8& pa2, bf16x8& pa3) {
#pragma unroll
    for (int r = 0; r < 16; ++r) p1[r] = __builtin_amdgcn_exp2f(p1[r]);
    float ps = 0;
#pragma unroll
    for (int r = 0; r < 16; ++r) ps += p0[r];
#pragma unroll
    for (int r = 0; r < 16; ++r) ps += p1[r];
    { auto rr = __builtin_amdgcn_permlane32_swap(__float_as_uint(ps), __float_as_uint(ps), false, false);
      ps = __uint_as_float(rr[0]) + __uint_as_float(rr[1]); }
    l_reg = l_reg * alpha + ps;
#define PK4(P, B_, OUT) do { unsigned a0 = cvtpk_s(P[B_+0], P[B_+1]), a1 = cvtpk_s(P[B_+2], P[B_+3]);                      \
        unsigned b0 = cvtpk_s(P[B_+4], P[B_+5]), b1 = cvtpk_s(P[B_+6], P[B_+7]);        \
        auto r0 = __builtin_amdgcn_permlane32_swap(a0, b0, false, false); auto r1 = __builtin_amdgcn_permlane32_swap(a1, b1, false, false); \
        u32x4 w = {r0[0], r1[0], r0[1], r1[1]}; OUT = *reinterpret_cast<bf16x8*>(&w); } while (0)
    PK4(p0, 0, pa0); PK4(p0, 8, pa1); PK4(p1, 0, pa2); PK4(p1, 8, pa3);
#undef PK4
}
__device__ __forceinline__ void qkt(f32x16& p0, f32x16& p1, const char* Kbuf  , int r32, int hi, const bf16x8* qr, const f32x16& ab) {
    const char* kb[4];
#pragma unroll
    for (int dd = 0; dd < 4; ++dd) kb[dd] = Kbuf + KSWZ(r32, (dd * 16 + hi * 8) * 2);
#pragma unroll
    for (int d0 = 0; d0 < 8; ++d0) { const char* a = kb[d0 & 3] + (d0 >> 2) * 128;
        bf16x8 b0 = *reinterpret_cast<const bf16x8*>(a);
        bf16x8 b1 = *reinterpret_cast<const bf16x8*>(a + 32 * 256);
        if (d0 == 0) { p0 = __builtin_amdgcn_mfma_f32_32x32x16_bf16(b0, qr[0], ab, 0, 0, 0); p1 = __builtin_amdgcn_mfma_f32_32x32x16_bf16(b1, qr[0], ab, 0, 0, 0); }
        else { p0 = __builtin_amdgcn_mfma_f32_32x32x16_bf16(b0, qr[d0], p0, 0, 0, 0); p1 = __builtin_amdgcn_mfma_f32_32x32x16_bf16(b1, qr[d0], p1, 0, 0, 0); } }
}
__device__ __forceinline__ void pv_tile(f32x16* o, int vb0  , bf16x8 pa0, bf16x8 pa1, bf16x8 pa2, bf16x8 pa3) {
#define TRRD(dst, off) asm volatile("ds_read_b64_tr_b16 %0, %1 offset:%2" : "=&v"(dst) : "v"(vb0), "i"(off) : "memory")
#define PV_D0(d0) do { s16x4 l0, l1, l2, l3, h0, h1, h2, h3; constexpr int b_ = v_rd_off(d0, 0, 0); \
        TRRD(l0, b_); TRRD(h0, b_ + 2048); TRRD(l1, b_ + 4096); TRRD(h1, b_ + 6144); TRRD(l2, b_ + 8192); TRRD(h2, b_ + 10240); TRRD(l3, b_ + 12288); TRRD(h3, b_ + 14336); \
        asm volatile("s_waitcnt lgkmcnt(0)" ::: "memory"); SBAR();   \
        o[d0] = __builtin_amdgcn_mfma_f32_32x32x16_bf16(pa0, (bf16x8){l0[0], l0[1], l0[2], l0[3], h0[0], h0[1], h0[2], h0[3]}, o[d0], 0, 0, 0);   \
        o[d0] = __builtin_amdgcn_mfma_f32_32x32x16_bf16(pa1, (bf16x8){l1[0], l1[1], l1[2], l1[3], h1[0], h1[1], h1[2], h1[3]}, o[d0], 0, 0, 0);   \
        o[d0] = __builtin_amdgcn_mfma_f32_32x32x16_bf16(pa2, (bf16x8){l2[0], l2[1], l2[2], l2[3], h2[0], h2[1], h2[2], h2[3]}, o[d0], 0, 0, 0);   \
        o[d0] = __builtin_amdgcn_mfma_f32_32x32x16_bf16(pa3, (bf16x8){l3[0], l3[1], l3[2], l3[3], h3[0], h3[1], h3[2], h3[3]}, o[d0], 0, 0, 0); } while (0)
    PV_D0(0); PV_D0(1); PV_D0(2); PV_D0(3);
#undef PV_D0
#undef TRRD
}

struct BlockRef { const bf16_t* Q; const bf16_t* K; const bf16_t* V; const bf16_t* Z; bf16_t* O; const float* KM; int qb; float slopeR;
                  int jlo, ntp;
                  float* part; unsigned* cnt; };
struct Seam { bf16x8 qr[8]; int bb; };

#define VMW() asm volatile("s_waitcnt vmcnt(0)" ::: "memory")
#define VMWN(n) asm volatile("s_waitcnt vmcnt(%0)" :: "i"(n) : "memory")
struct DmaOff { unsigned k, v; };
__device__ __forceinline__ DmaOff dma_offsets(int wid, int lane) {
    DmaOff d; const int pc = wid * 2;
    const int row = pc * 4 + (lane >> 4), colB = ((lane & 15) * 16) ^ ((row & 7) << 4); d.k = (unsigned)(row * LDQ * 2 + colB);
    const int B = pc * 1024 + lane * 16, st = B >> 9, r8 = (B >> 6) & 7, cc = (B & 63) >> 1, kk = (st >> 2) * 8 + r8, c = (st & 3) * 32 + cc;
    const int k = (kk & ~0xC) | ((kk & 4) << 1) | ((kk & 8) >> 1); d.v = (unsigned)(k * LDQ * 2 + c * 2);
    return d;
}
typedef __attribute__((address_space(3))) unsigned LdsU;
__device__ __forceinline__ void dma_tile(const bf16_t* Kp, const bf16_t* Vp, int k0, char* lds, int buf, int wid, const DmaOff& d) {
    const char* kq = (const char*)(Kp + (size_t)k0 * LDQ); const char* vq = (const char*)(Vp + (size_t)k0 * LDQ);
    LdsU* kl = (LdsU*)(lds + NB * SHM_V + buf * SHM_K + wid * 2048); LdsU* vl = (LdsU*)(lds + buf * SHM_V + wid * 2048);
    unsigned ko = d.k, vo = d.v; asm volatile("" : "+v"(ko), "+v"(vo));
    __builtin_amdgcn_global_load_lds((const unsigned*)(kq + ko), kl, 16, 0, 0);
    __builtin_amdgcn_global_load_lds((const unsigned*)(vq + vo), vl, 16, 0, 0);
    const unsigned ko1 = (ko ^ 64u) + 4u * (unsigned)(LDQ * 2), vo1 = vo + 128u;
    __builtin_amdgcn_global_load_lds((const unsigned*)(kq + ko1), kl + 256, 16, 0, 0);
    __builtin_amdgcn_global_load_lds((const unsigned*)(vq + vo1), vl + 256, 16, 0, 0);
}
__device__ __forceinline__ void prime(const BlockRef& cur, char* lds, Seam& S, int tid) {
    const int wid = __builtin_amdgcn_readfirstlane(tid >> 6), lane = tid & 63, r32 = lane & 31, hi = lane >> 5;
    const unsigned qoff = (unsigned)((wid * QBLK + r32) * LDQ + hi * 8) * 2u;
    const DmaOff d = dma_offsets(wid, lane);
    S.bb = 0; dma_tile(cur.K, cur.V, (cur.jlo + cur.ntp - 1) * KVBLK, lds, 0, wid, d);
#pragma unroll
    for (int d0 = 0; d0 < 8; ++d0) S.qr[d0] = *(const bf16x8*)((const char*)cur.Q + qoff + d0 * 32);
    VMW(); __syncthreads();
}
__device__ __forceinline__ unsigned select_blocks(const Seam& S, const float* KM, int qb, int hi, int r32) {
    if (qb <= 3) return (1u << qb) - 1u;
    const int n = r32 & 15; const bool live = r32 < 16 && n < qb;
    const float* km = KM + (live ? n : 0) * KMT_LD + hi * 8;
    f32x4 kv[8][2];
#pragma unroll
    for (int d0 = 0; d0 < 8; ++d0) { kv[d0][0] = *(const f32x4*)(km + d0 * 16); kv[d0][1] = *(const f32x4*)(km + d0 * 16 + 4); }
    f32x16 p = {};
#pragma unroll
    for (int d0 = 0; d0 < 8; ++d0) { u32x4 w; w.x = pk2(kv[d0][0].x, kv[d0][0].y); w.y = pk2(kv[d0][0].z, kv[d0][0].w); w.z = pk2(kv[d0][1].x, kv[d0][1].y); w.w = pk2(kv[d0][1].z, kv[d0][1].w);
        if (!live) w = (u32x4){0u, 0u, 0u, 0u};
        p = __builtin_amdgcn_mfma_f32_32x32x16_bf16(__builtin_bit_cast(bf16x8, w), S.qr[d0], p, 0, 0, 0); }
    float g[16];
#pragma unroll
    for (int r = 0; r < 8; ++r) { const float own = p[r];
        auto rr = __builtin_amdgcn_permlane32_swap(__float_as_uint(own), __float_as_uint(own), false, false);
        const float oth = __uint_as_float(hi ? rr[0] : rr[1]);
        const int nlo = (r & 3) + 8 * (r >> 2);
        g[nlo] = hi ? oth : own; g[nlo + 4] = hi ? own : oth; }
    unsigned sel = 0u;
#pragma unroll
    for (int it = 0; it < 3; ++it) { float best = -__builtin_inff(); int bi = 0;
#pragma unroll
        for (int n2 = 0; n2 < 15; ++n2) { const bool c = n2 < qb && !((sel >> n2) & 1u) && g[n2] > best; best = c ? g[n2] : best; bi = c ? n2 : bi; }
        sel |= 1u << bi; }
    return sel;
}
__device__ __forceinline__ void block(const BlockRef& cur, const bf16_t* nQ, int nlast, unsigned sel, char* lds, Seam& S, int tid) {
    const int wid = __builtin_amdgcn_readfirstlane(tid >> 6), lane = tid & 63, r32 = lane & 31, hi = lane >> 5;
    const int qb = cur.qb, NTF = 4 * (qb + 1), NT = cur.ntp, jlo = cur.jlo;
    const int qlo = wid * QBLK, qm = qlo + r32 - 4 * hi;
    char* V_lds = lds; char* K_lds = lds + NB * SHM_V;
    float* ws = (float*)(lds + OFF_WS) + wid * 64; float* li_l = ws, * al_l = ws + 32;
    float m_reg = -1e30f, l_reg = 0; f32x16 o[4] = {};
    const int vb0 = (int)(uintptr_t)V_lds + v_rd_base(lane);
    const DmaOff dmo = dma_offsets(wid, lane);
    const bf16_t* Kh = cur.K; const bf16_t* Vh = cur.V;
    const float slopeR = cur.slopeR, hb = slopeR * (float)(4 * hi);
    f32x16 AB;
#pragma unroll
    for (int r = 0; r < 16; ++r) AB[r] = slopeR * (float)((r & 3) + 8 * (r >> 2));
#define RESC(a) do { if (__any((a) < 1.f)) { if (hi == 0) al_l[r32] = (a); asm volatile("s_waitcnt lgkmcnt(0)" ::: "memory");              \
                     for (int d_ = 0; d_ < 4; ++d_) for (int r = 0; r < 16; ++r) o[d_][r] *= al_l[crow(r, hi)]; } } while (0)
#define TIDX(t) (jlo + NT - 1 - (t))
#define KBASE(t) (TIDX(t) * KVBLK)
#define MASKT(P0_, P1_, t) do { const int kr_ = KBASE(t) - 256 * qb;                                              \
        if (TIDX(t) >= NTF - 4) { if (kr_ + KVBLK - 1 > qlo) mask_causal(P0_, P1_, qm - kr_); }                                                \
        keep_ = (TIDX(t) >= NTF - 4) || (((sel >> (TIDX(t) >> 2)) & 1u) != 0u);                                                                \
        tb0_ = fmaf(slopeR, (float)kr_, hb); tb1_ = tb0_ + 32.f * slopeR; } while (0)
    f32x16 pA0, pA1, pB0, pB1; float mnA, mnB, alA, alB; bf16x8 pa0, pa1, pa2, pa3; float tb0_, tb1_; bool keep_;
    int bprev = S.bb, bcur = bprev == 2 ? 0 : bprev + 1, bnext = bcur == 2 ? 0 : bcur + 1;
#define LBAR() do { asm volatile("s_waitcnt vmcnt(0) lgkmcnt(0)" ::: "memory"); __builtin_amdgcn_s_barrier(); SBAR(); } while (0)
#define ROT() do { const int t_ = bprev; bprev = bcur; bcur = bnext; bnext = t_; } while (0)
    dma_tile(Kh, Vh, KBASE(1), lds, bcur, wid, dmo);
    SBAR(); qkt(pA0, pA1, K_lds + bprev * SHM_K, r32, hi, S.qr, AB);
    MASKT(pA0, pA1, 0); partialSM(pA0, pA1, m_reg, mnA, alA, tb0_, tb1_, keep_);
    LBAR();
#define SGB_QF() do { __builtin_amdgcn_sched_group_barrier(0x100, 2, 0); _Pragma("unroll") for (int i_ = 0; i_ < 8; ++i_) { __builtin_amdgcn_sched_group_barrier(0x100, 2, 0); \
        __builtin_amdgcn_sched_group_barrier(0x8, 1, 0); __builtin_amdgcn_sched_group_barrier(0x400, 1, 0); __builtin_amdgcn_sched_group_barrier(0x2, 3, 0); \
        __builtin_amdgcn_sched_group_barrier(0x8, 1, 0); __builtin_amdgcn_sched_group_barrier(0x400, 1, 0); __builtin_amdgcn_sched_group_barrier(0x2, 3, 0); } } while (0)
#define HALF_STEP(PX0, PX1, mnX, alX, PY0, PY1, alY, t) do {                                                                   \
        if ((t) + 1 < NT) dma_tile(Kh, Vh, KBASE((t) + 1), lds, bnext, wid, dmo);                                             \
        SBAR(); qkt(PX0, PX1, K_lds + bcur * SHM_K, r32, hi, S.qr, AB);                                                           \
        finishSM(PY0, PY1, alY, l_reg, pa0, pa1, pa2, pa3); SBAR();                                                           \
        pv_tile(o, vb0 + bprev * SHM_V, pa0, pa1, pa2, pa3); MASKT(PX0, PX1, (t)); partialSM(PX0, PX1, m_reg, mnX, alX, tb0_, tb1_, keep_);      \
        RESC(alX); LBAR(); ROT(); } while (0)
    for (int t = 1; t + 1 < NT; t += 2) {
        HALF_STEP(pB0, pB1, mnB, alB, pA0, pA1, alA, t);
        HALF_STEP(pA0, pA1, mnA, alA, pB0, pB1, alB, t + 1);
    }
    dma_tile(Kh, Vh, nlast * KVBLK, lds, bnext, wid, dmo); S.bb = bnext;
    SBAR(); qkt(pB0, pB1, K_lds + bcur * SHM_K, r32, hi, S.qr, AB); SBAR();
    { const int le_ = opaque_lane(); const unsigned qoff = (unsigned)((wid * QBLK + (le_ & 31)) * LDQ + (le_ >> 5) * 8) * 2u;
#pragma unroll
      for (int d0 = 0; d0 < 8; ++d0) S.qr[d0] = *(const bf16x8*)((const char*)nQ + qoff + d0 * 32); }
    SBAR();
    finishSM(pA0, pA1, alA, l_reg, pa0, pa1, pa2, pa3); SBAR();
    pv_tile(o, vb0 + bprev * SHM_V, pa0, pa1, pa2, pa3);
    MASKT(pB0, pB1, NT - 1); partialSM(pB0, pB1, m_reg, mnB, alB, tb0_, tb1_, keep_); RESC(alB);
    finishSM(pB0, pB1, alB, l_reg, pa0, pa1, pa2, pa3); SBAR(); pv_tile(o, vb0 + bcur * SHM_V, pa0, pa1, pa2, pa3);
    SBAR();
#undef LBAR
#undef ROT
    bool do_epi = true;
    if (cur.part) {
        volatile unsigned* flg = (volatile unsigned*)(lds + OFF_WS + NW * 64 * 4);
        if (tid == 0) flg[0] = __hip_atomic_fetch_add(cur.cnt, 1u, __ATOMIC_RELAXED, __HIP_MEMORY_SCOPE_AGENT);
        __syncthreads();
        const unsigned ticket = flg[0];
        float* pp = cur.part + tid;
        if (ticket == 0u) {
#pragma unroll
            for (int d0 = 0; d0 < 4; ++d0)
#pragma unroll
                for (int r = 0; r < 16; ++r) pp[(d0 * 16 + r) * 512] = o[d0][r];
            pp[64 * 512] = m_reg; pp[65 * 512] = l_reg;
            asm volatile("s_waitcnt vmcnt(0)" ::: "memory"); __syncthreads();
            if (tid == 0) { __builtin_amdgcn_fence(__ATOMIC_RELEASE, "agent"); asm volatile("s_waitcnt vmcnt(0)" ::: "memory");
                __hip_atomic_store(cur.cnt + 1, 1u, __ATOMIC_RELAXED, __HIP_MEMORY_SCOPE_AGENT); }
            do_epi = false;
        } else {
            if (tid == 0) { unsigned sp = 0; while (__hip_atomic_load(cur.cnt + 1, __ATOMIC_RELAXED, __HIP_MEMORY_SCOPE_AGENT) == 0u && ++sp < (1u << 22)) __builtin_amdgcn_s_sleep(2);
                __builtin_amdgcn_fence(__ATOMIC_ACQUIRE, "agent"); asm volatile("s_waitcnt vmcnt(0)" ::: "memory"); }
            __syncthreads();
            constexpr float C2 = 1.4426950408889634f * SCALE;
            float pb0[64];
#pragma unroll
            for (int r = 0; r < 64; ++r) pb0[r] = pp[r * 512];
            const float mb = pp[64 * 512], lb = pp[65 * 512], mm = fmaxf(m_reg, mb);
            const float fa = __builtin_amdgcn_exp2f((m_reg - mm) * C2), fb = __builtin_amdgcn_exp2f((mb - mm) * C2);
            l_reg = l_reg * fa + lb * fb;
            if (hi == 0) { al_l[r32] = fa; li_l[r32] = fb; } asm volatile("s_waitcnt lgkmcnt(0)" ::: "memory");
#pragma unroll
            for (int d0 = 0; d0 < 4; ++d0)
#pragma unroll
                for (int r = 0; r < 16; ++r) o[d0][r] = o[d0][r] * al_l[crow(r, hi)] + pb0[d0 * 16 + r] * li_l[crow(r, hi)];
            asm volatile("s_waitcnt lgkmcnt(0)" ::: "memory");
        }
    }
    if (do_epi) {
    int le = lane; asm volatile("" : "+v"(le));
    const bf16_t* Zw = cur.Z + (size_t)(wid * QBLK) * LDQ;
    u32x4 zr[2][4];
#pragma unroll
    for (int hlf = 0; hlf < 2; ++hlf)
#pragma unroll
        for (int i = 0; i < 4; ++i) zr[hlf][i] = *(const u32x4*)(Zw + (size_t)(i * 8 + (le >> 3)) * LDQ + hlf * 64 + (le & 7) * 8);
    if (hi == 0) li_l[r32] = l_reg; asm volatile("s_waitcnt lgkmcnt(0)" ::: "memory");
    float rli[16];
#pragma unroll
    for (int r = 0; r < 16; ++r) rli[r] = __builtin_amdgcn_rcpf(li_l[crow(r, hi)]);
    __syncthreads();
    bf16_t* Ow = cur.O + (size_t)(wid * QBLK) * LDO;
    bf16_t* stg = (bf16_t*)(lds + OFF_STG) + wid * 2048;
#pragma unroll
    for (int hlf = 0; hlf < 2; ++hlf) {
#pragma unroll
        for (int r = 0; r < 16; ++r) { const int orow = crow(r, hi);
            stg[orow * 64 + r32] = (bf16_t)f2bf(o[2 * hlf][r] * rli[r]); stg[orow * 64 + 32 + r32] = (bf16_t)f2bf(o[2 * hlf + 1][r] * rli[r]); }
        asm volatile("s_waitcnt lgkmcnt(0)" ::: "memory");
#pragma unroll
        for (int i = 0; i < 4; ++i) { const int row = i * 8 + (le >> 3), ch = le & 7;
            float ov[8], zv[8]; unpack8(*(const u32x4*)(stg + row * 64 + ch * 8), ov); unpack8(zr[hlf][i], zv);
#pragma unroll
            for (int j = 0; j < 8; ++j) ov[j] *= zv[j];
            *(u32x4*)(Ow + (size_t)row * LDO + hlf * 64 + ch * 8) = pack8(ov); }
        asm volatile("s_waitcnt lgkmcnt(0)" ::: "memory");
    }
    } else __syncthreads();
    __syncthreads();
#undef RESC
#undef KBASE
#undef TIDX
#undef MASKT
#undef HALF_STEP
#undef SGB_QF
}
#undef VMW
#undef VMWN
__device__ __forceinline__ void mixer_a_chunk(const bf16_t* AV, const bf16_t* UZ, bf16_t* UZOUT, const bf16_t* WA  , const float* lng, const float* lnb, const float* bs  , int chunk, char* lds, int tid) {
    const int wid = __builtin_amdgcn_readfirstlane(tid >> 6), lane = tid & 63, r32 = lane & 31, hi = lane >> 5;
    const int r0 = chunk * 128;
    { float lg[8], lb[8];
#pragma unroll
      for (int j = 0; j < 8; ++j) { lg[j] = lng[lane * 8 + j]; lb[j] = lnb[lane * 8 + j]; }
      char* vdst = lds + (2 * (lane >> 4)) * SHM_V;
      u32x4 rawA[16];
#pragma unroll
      for (int i = 0; i < 16; ++i) rawA[i] = *(const u32x4*)(AV + (size_t)(r0 + wid + NW * i) * 512 + lane * 8);
#pragma unroll
      for (int i = 0; i < 16; ++i) { const int tt = wid + NW * i;
        const u32x4 raw = rawA[i]; float f[8]; unpack8(raw, f);
        float sm = 0.f;
#pragma unroll
        for (int j = 0; j < 8; ++j) sm += f[j];
        const float mean = wave_sum(sm) * (1.0f / 512.0f); float q = 0.f;
#pragma unroll
        for (int j = 0; j < 8; ++j) { f[j] -= mean; q += f[j] * f[j]; }
        const float rstd = 1.0f / sqrtf(wave_sum(q) * (1.0f / 512.0f) + EPS);
#pragma unroll
        for (int j = 0; j < 8; ++j) f[j] = f[j] * rstd * lg[j] + lb[j];
        *(u32x4*)(vdst + (tt >> 6) * SHM_V + v_st(tt & 63, (lane & 15) * 8)) = pack8(f);
      } }
    __syncthreads();
    bf16_t* stg = (bf16_t*)(lds + 131072) + wid * 1024;
#pragma unroll 1
    for (int ti = 0; ti < 2; ++ti) {
        const int task = wid + 8 * ti, g = task & 3, rb = task >> 2;
        f32x16 o[4] = {};
        const bf16_t* wrow = WA + ((size_t)g * 128 + 32 * rb + r32) * 128 + 8 * hi;
        bf16x8 pa[2][4];
#pragma unroll
        for (int tile = 0; tile < 2; ++tile)
#pragma unroll
            for (int k4 = 0; k4 < 4; ++k4) pa[tile][k4] = load8(wrow + 64 * (tile <= (rb >> 1) ? tile : 0) + 16 * k4);
        float bsv[16];
#pragma unroll
        for (int r = 0; r < 16; ++r) bsv[r] = bs[g * 128 + 32 * rb + crow(r, hi)];
        u32x4 uzv[4][2];
#pragma unroll
        for (int d0 = 0; d0 < 4; ++d0)
#pragma unroll
            for (int i = 0; i < 2; ++i) { const int pc = lane + 64 * i; uzv[d0][i] = *(const u32x4*)(UZ + (size_t)(r0 + 32 * rb + (pc >> 2)) * 512 + g * 128 + d0 * 32 + (pc & 3) * 8); }
        { const int vb = (int)(uintptr_t)lds + (2 * g) * SHM_V + v_rd_base(lane); pv_tile(o, vb, pa[0][0], pa[0][1], pa[0][2], pa[0][3]); }
        if (rb >> 1) { const int vb = (int)(uintptr_t)lds + (2 * g + 1) * SHM_V + v_rd_base(lane); pv_tile(o, vb, pa[1][0], pa[1][1], pa[1][2], pa[1][3]); }
#pragma unroll
        for (int d0 = 0; d0 < 4; ++d0) {
#pragma unroll
            for (int r = 0; r < 16; ++r) stg[crow(r, hi) * 32 + r32] = (bf16_t)f2bf(o[d0][r] + bsv[r]);
            asm volatile("s_waitcnt lgkmcnt(0)" ::: "memory");
#pragma unroll
            for (int i = 0; i < 2; ++i) { const int pc = lane + 64 * i, row = pc >> 2, ch = pc & 3;
                float mv[8], uv[8]; unpack8(*(const u32x4*)(stg + row * 32 + ch * 8), mv);
                const size_t uo = (size_t)(r0 + 32 * rb + row) * 512 + g * 128 + d0 * 32 + ch * 8; unpack8(uzv[d0][i], uv);
#pragma unroll
                for (int j = 0; j < 8; ++j) uv[j] *= mv[j];
                *(u32x4*)(UZOUT + uo) = pack8(uv); }
            asm volatile("s_waitcnt lgkmcnt(0)" ::: "memory");
        }
    }
    __syncthreads();
}
constexpr int GCH = 4, NGRP = SEQ / 64 / GCH;
constexpr int GL_QT = 0, GL_KT = 9216, GL_KD = 18432, GL_VT = 34816, GL_SB = 51200, GL_EB = 83968, GL_W2 = 84224, GL_END = 88320;
__device__ __forceinline__ void gla_local(const bf16_t* CQK, const bf16_t* CV, const float* LRF  , const float* w2  , const float* b2  , bf16_t* OL  , bf16_t* QTO  , float* BLO  , float* TT  , float* DGO  ,
                                          int bl, int h, int g, char* lds, int tid) {
    const int wid = __builtin_amdgcn_readfirstlane(tid >> 6), lane = tid & 63, r32 = lane & 31, hi = lane >> 5;
    const int x = wid >> 2, vb = wid & 3;
    const int sr = tid >> 4, sc = (tid & 15) * 8;
    const int ldsb = (int)(uintptr_t)lds;
    f32x16 S = {}; bf16x8 sfr0 = {}, sfr1 = {};
    float dgs[8];
#pragma unroll
    for (int j = 0; j < 8; ++j) dgs[j] = 0.f;
    f32x4 lrA[2][4]; u32x4 qvA[2], kvA[2], vv0A[2], vv1A[2];
    { float* w2s = (float*)(lds + GL_W2);
      for (int i = tid; i < 16 * 64; i += 512) w2s[i] = w2[(i >> 6) * 256 + h * 64 + (i & 63)]; }
    float b2v[8];
#pragma unroll
    for (int j = 0; j < 8; ++j) b2v[j] = b2[h * 64 + 8 * wid + j];
#define GLA_LOAD(c, st) do { const size_t row0_ = (size_t)bl * SEQ + (size_t)(g * GCH + (c)) * 64;                                       \
        const f32x4* lp_ = (const f32x4*)(LRF + (row0_ + lane) * 16); lrA[st][0] = lp_[0]; lrA[st][1] = lp_[1]; lrA[st][2] = lp_[2]; lrA[st][3] = lp_[3];  \
        const bf16_t* qp_ = CQK + (row0_ + lane) * 512 + h * 64 + 8 * wid; qvA[st] = *(const u32x4*)qp_; kvA[st] = *(const u32x4*)(qp_ + 256);  \
        const bf16_t* vp_ = CV + (row0_ + sr) * 512 + h * 128 + sc; vv0A[st] = *(const u32x4*)vp_; vv1A[st] = *(const u32x4*)(vp_ + 32 * 512); } while (0)
    GLA_LOAD(0, 0); GLA_LOAD(1, 1);
    __syncthreads();
#pragma unroll
    for (int c = 0; c < GCH; ++c) {
        const size_t row0 = (size_t)bl * SEQ + (size_t)(g * GCH + c) * 64;
        const f32x4 lr0 = lrA[c & 1][0], lr1 = lrA[c & 1][1], lr2 = lrA[c & 1][2], lr3 = lrA[c & 1][3]; const u32x4 qv = qvA[c & 1], kv = kvA[c & 1], vv0 = vv0A[c & 1], vv1 = vv1A[c & 1];
        { float b[8];
#define DPP_ADD(v, ctrl, rmask) do { const int t_ = __builtin_amdgcn_update_dpp(0, __builtin_bit_cast(int, v), ctrl, rmask, 0xf, false); v += __builtin_bit_cast(float, t_); } while (0)
          { const float lr[16] = {lr0.x, lr0.y, lr0.z, lr0.w, lr1.x, lr1.y, lr1.z, lr1.w, lr2.x, lr2.y, lr2.z, lr2.w, lr3.x, lr3.y, lr3.z, lr3.w};
            float xs[8];
#pragma unroll
            for (int j = 0; j < 8; ++j) xs[j] = b2v[j];
            const float* w2s = (const float*)(lds + GL_W2) + 8 * wid;
#pragma unroll
            for (int r = 0; r < 16; ++r) { const f32x4 wa = *(const f32x4*)(w2s + r * 64), wb = *(const f32x4*)(w2s + r * 64 + 4);
                xs[0] += lr[r] * wa.x; xs[1] += lr[r] * wa.y; xs[2] += lr[r] * wa.z; xs[3] += lr[r] * wa.w; xs[4] += lr[r] * wb.x; xs[5] += lr[r] * wb.y; xs[6] += lr[r] * wb.z; xs[7] += lr[r] * wb.w; }
#pragma unroll
            for (int j = 0; j < 8; ++j) b[j] = (fminf(xs[j], 0.f) * 1.4426950408889634f - __builtin_amdgcn_logf(1.0f + __builtin_amdgcn_exp2f(-fabsf(xs[j]) * 1.4426950408889634f))) * (1.0f / 16.0f); }
#pragma unroll
          for (int j = 0; j < 8; ++j) { float v_ = b[j];
              DPP_ADD(v_, 0x111, 0xf); DPP_ADD(v_, 0x112, 0xf); DPP_ADD(v_, 0x114, 0xf); DPP_ADD(v_, 0x118, 0xf); DPP_ADD(v_, 0x142, 0xa); DPP_ADD(v_, 0x143, 0xc); b[j] = v_; }
#undef DPP_ADD
          float qf_[8], kf_[8], qt[8], kt[8], kd[8], blv[8]; unpack8(qv, qf_); unpack8(kv, kf_);
#pragma unroll
          for (int j = 0; j < 8; ++j) { const float bl_ = __builtin_bit_cast(float, __builtin_amdgcn_readlane(__builtin_bit_cast(int, b[j]), 63)); blv[j] = bl_; const float eq = __builtin_amdgcn_exp2f(b[j]), ek = __builtin_amdgcn_exp2f(-b[j]), ed = __builtin_amdgcn_exp2f(bl_ - b[j]);
              qt[j] = qf_[j] * 0.125f * eq; kt[j] = kf_[j] * ek; kd[j] = kf_[j] * ed; }
          if (lane == 63) { float* bo = BLO + (row0 >> 6) * 256 + h * 64 + 8 * wid; float* eb = (float*)(lds + GL_EB) + 8 * wid;
#pragma unroll
              for (int j = 0; j < 8; ++j) { eb[j] = __builtin_amdgcn_exp2f(blv[j]); bo[j] = blv[j]; dgs[j] += blv[j]; } }
          const u32x4 qpk = pack8(qt);
          *(u32x4*)(QTO + (row0 + lane) * 256 + h * 64 + 8 * wid) = qpk;
          *(u32x4*)(lds + GL_QT + lane * 144 + wid * 16) = qpk;
          *(u32x4*)(lds + GL_KT + lane * 144 + wid * 16) = pack8(kt);
          *(u32x4*)(lds + GL_KD + v_st(lane, 8 * wid)) = pack8(kd);
          *(u32x4*)(lds + GL_VT + v_st(sr, sc)) = vv0; *(u32x4*)(lds + GL_VT + v_st(32 + sr, sc)) = vv1; }
        __syncthreads();
        if (c + 2 < GCH) GLA_LOAD(c + 2, c & 1);
        { bf16x8 qf[4];
#pragma unroll
          for (int ks = 0; ks < 4; ++ks) qf[ks] = *(const bf16x8*)(lds + GL_QT + (32 * x + r32) * 144 + (16 * ks + 8 * hi) * 2);
          f32x16 p0 = {}, p1 = {};
#pragma unroll
          for (int ks = 0; ks < 4; ++ks) { const bf16x8 kf = *(const bf16x8*)(lds + GL_KT + r32 * 144 + (16 * ks + 8 * hi) * 2); p0 = __builtin_amdgcn_mfma_f32_32x32x16_bf16(kf, qf[ks], p0, 0, 0, 0); }
          if (x == 1) {
#pragma unroll
              for (int ks = 0; ks < 4; ++ks) { const bf16x8 kf = *(const bf16x8*)(lds + GL_KT + (32 + r32) * 144 + (16 * ks + 8 * hi) * 2); p1 = __builtin_amdgcn_mfma_f32_32x32x16_bf16(kf, qf[ks], p1, 0, 0, 0); } }
          if (x == 0) {
#pragma unroll
              for (int r = 0; r < 16; ++r) p0[r] = (crow(r, hi) <= r32) ? p0[r] : 0.f;
          } else {
#pragma unroll
              for (int r = 0; r < 16; ++r) p1[r] = (crow(r, hi) <= r32) ? p1[r] : 0.f;
          }
          bf16x8 pa0, pa1, pa2, pa3;
#define PK4(P, B_, OUT) do { unsigned a0 = cvtpk_s(P[B_+0], P[B_+1]), a1 = cvtpk_s(P[B_+2], P[B_+3]);                          \
        unsigned b0 = cvtpk_s(P[B_+4], P[B_+5]), b1 = cvtpk_s(P[B_+6], P[B_+7]);                                             \
        auto r0 = __builtin_amdgcn_permlane32_swap(a0, b0, false, false); auto r1 = __builtin_amdgcn_permlane32_swap(a1, b1, false, false); \
        u32x4 w = {r0[0], r1[0], r0[1], r1[1]}; OUT = *reinterpret_cast<bf16x8*>(&w); } while (0)
          PK4(p0, 0, pa0); PK4(p0, 8, pa1); PK4(p1, 0, pa2); PK4(p1, 8, pa3);
#undef PK4
          s16x4 vl[4], vh[4], kl[4], kh[4];
          const int vbase = ldsb + GL_VT + v_rd_base(lane), kbase = ldsb + GL_KD + v_rd_base(lane);
#define TRRDV(dst, base, off) asm volatile("ds_read_b64_tr_b16 %0, %1" : "=&v"(dst) : "v"((base) + (off)) : "memory")
#pragma unroll
          for (int ks = 0; ks < 4; ++ks) { TRRDV(vl[ks], vbase, vb * 512 + ks * 4096); TRRDV(vh[ks], vbase, vb * 512 + ks * 4096 + 2048); TRRDV(kl[ks], kbase, x * 512 + ks * 4096); TRRDV(kh[ks], kbase, x * 512 + ks * 4096 + 2048); }
#undef TRRDV
          asm volatile("s_waitcnt lgkmcnt(0)" ::: "memory"); SBAR();
#define FR8(l_, h_) (bf16x8){l_[0], l_[1], l_[2], l_[3], h_[0], h_[1], h_[2], h_[3]}
          f32x16 o = {};
          o = __builtin_amdgcn_mfma_f32_32x32x16_bf16(pa0, FR8(vl[0], vh[0]), o, 0, 0, 0);
          o = __builtin_amdgcn_mfma_f32_32x32x16_bf16(pa1, FR8(vl[1], vh[1]), o, 0, 0, 0);
          if (x == 1) { o = __builtin_amdgcn_mfma_f32_32x32x16_bf16(pa2, FR8(vl[2], vh[2]), o, 0, 0, 0); o = __builtin_amdgcn_mfma_f32_32x32x16_bf16(pa3, FR8(vl[3], vh[3]), o, 0, 0, 0); }
          if (c > 0) {
              const char* sbp = lds + GL_SB + (c & 1) * 16384 + ((1 - x) * 4 + vb) * 2048 + lane * 16;
              const bf16x8 pf0 = *(const bf16x8*)sbp, pf1 = *(const bf16x8*)(sbp + 1024);
#pragma unroll
              for (int db = 0; db < 2; ++db)
#pragma unroll
                  for (int s2 = 0; s2 < 2; ++s2) {
                      const char* qa = lds + GL_QT + (32 * x + r32) * 144 + (32 * db + 16 * s2 + 4 * hi) * 2;
                      const s16x4 a_lo = *(const s16x4*)qa, a_hi = *(const s16x4*)(qa + 16);
                      const bf16x8 af = FR8(a_lo, a_hi);
                      const bf16x8 sf = (db == x) ? (s2 == 0 ? sfr0 : sfr1) : (s2 == 0 ? pf0 : pf1);
                      o = __builtin_amdgcn_mfma_f32_32x32x16_bf16(af, sf, o, 0, 0, 0);
                  }
          }
          { const float* eb = (const float*)(lds + GL_EB) + 32 * x;
#pragma unroll
            for (int r = 0; r < 16; ++r) S[r] *= eb[crow(r, hi)]; }
#pragma unroll
          for (int ks = 0; ks < 4; ++ks) S = __builtin_amdgcn_mfma_f32_32x32x16_bf16(FR8(kl[ks], kh[ks]), FR8(vl[ks], vh[ks]), S, 0, 0, 0);
#undef FR8
          if (c + 1 < GCH) { u32x4 w0 = {cvtpk_s(S[0], S[1]), cvtpk_s(S[2], S[3]), cvtpk_s(S[4], S[5]), cvtpk_s(S[6], S[7])}, w1 = {cvtpk_s(S[8], S[9]), cvtpk_s(S[10], S[11]), cvtpk_s(S[12], S[13]), cvtpk_s(S[14], S[15])};
            sfr0 = __builtin_bit_cast(bf16x8, w0); sfr1 = __builtin_bit_cast(bf16x8, w1);
            char* sbw = lds + GL_SB + ((c + 1) & 1) * 16384 + wid * 2048 + lane * 16;
            *(bf16x8*)sbw = sfr0; *(bf16x8*)(sbw + 1024) = sfr1; }
          bf16_t* op = OL + (row0 + 32 * x) * 512 + h * 128 + 32 * vb + r32;
#pragma unroll
          for (int r = 0; r < 16; ++r) { const float v_ = o[r], vn = dpp_f(v_, DPP_QX1); if ((r32 & 1) == 0) *(unsigned*)(op + (size_t)crow(r, hi) * 512) = cvtpk_s(v_, vn); }
        }
        __syncthreads();
    }
#undef GLA_LOAD
    if (lane == 63) { float* dp = DGO + (size_t)((bl * 4 + h) * NGRP + g) * 64 + 8 * wid;
#pragma unroll
        for (int j = 0; j < 8; ++j) dp[j] = dgs[j]; }
    { float* tp = TT + ((size_t)((bl * 4 + h) * NGRP + g) * 128 + 32 * vb + r32) * 64 + 32 * x + 4 * hi;
#pragma unroll
      for (int q = 0; q < 4; ++q) *(f32x4*)(tp + 8 * q) = (f32x4){S[4 * q], S[4 * q + 1], S[4 * q + 2], S[4 * q + 3]}; }
}
constexpr int GF_ST = 0, GF_QH = 18432, GF_BG = 55296, GF_TL = 56320, GF_TLP = 264, GF_END = GF_TL + 256 * GF_TLP;
__device__ __forceinline__ void gla_fix(const bf16_t* OL, const bf16_t* QTO, const float* BLO, const float* TT, const float* DGO, const bf16_t* CZ, bf16_t* YOUT, const float* ong, int bl, int h, int g, char* lds, int tid) {
    const int wid = __builtin_amdgcn_readfirstlane(tid >> 6), lane = tid & 63, r32 = lane & 31, hi = lane >> 5;
    const size_t row0 = (size_t)bl * SEQ + (size_t)g * GCH * 64;
    const int tr = tid >> 4, tc = (tid & 15) * 8;
    u32x4 tl[8];
#pragma unroll
    for (int i = 0; i < 8; ++i) tl[i] = *(const u32x4*)(OL + (row0 + tr + 32 * i) * 512 + h * 128 + tc);
    f32x16 o[4] = {};
    if (g > 0) {
        { const int v = tid >> 2, d0 = (tid & 3) * 16;
          float Sg[16];
#pragma unroll
          for (int j = 0; j < 16; ++j) Sg[j] = 0.f;
          for (int gp0 = 0; gp0 < g; gp0 += 4) {
              f32x4 tv[4][4], dv[4][4];
#pragma unroll
              for (int i = 0; i < 4; ++i) if (gp0 + i < g) {
                  const f32x4* tp = (const f32x4*)(TT + ((size_t)((bl * 4 + h) * NGRP + gp0 + i) * 128 + v) * 64 + d0);
                  const f32x4* dp = (const f32x4*)(DGO + (size_t)((bl * 4 + h) * NGRP + gp0 + i) * 64 + d0);
#pragma unroll
                  for (int j4 = 0; j4 < 4; ++j4) { tv[i][j4] = tp[j4]; dv[i][j4] = dp[j4]; } }
#pragma unroll
              for (int i = 0; i < 4; ++i) if (gp0 + i < g) {
#pragma unroll
                  for (int j4 = 0; j4 < 4; ++j4) {
                      Sg[4 * j4] = __builtin_amdgcn_exp2f(dv[i][j4].x) * Sg[4 * j4] + tv[i][j4].x; Sg[4 * j4 + 1] = __builtin_amdgcn_exp2f(dv[i][j4].y) * Sg[4 * j4 + 1] + tv[i][j4].y;
                      Sg[4 * j4 + 2] = __builtin_amdgcn_exp2f(dv[i][j4].z) * Sg[4 * j4 + 2] + tv[i][j4].z; Sg[4 * j4 + 3] = __builtin_amdgcn_exp2f(dv[i][j4].w) * Sg[4 * j4 + 3] + tv[i][j4].w; } }
          }
          float f0[8] = {Sg[0], Sg[1], Sg[2], Sg[3], Sg[4], Sg[5], Sg[6], Sg[7]}, f1[8] = {Sg[8], Sg[9], Sg[10], Sg[11], Sg[12], Sg[13], Sg[14], Sg[15]};
          *(u32x4*)(lds + GF_ST + v * 144 + d0 * 2) = pack8(f0); *(u32x4*)(lds + GF_ST + v * 144 + d0 * 2 + 16) = pack8(f1); }
        if (tid < 64) { float acc = 0.f; float* bgp = (float*)(lds + GF_BG);
#pragma unroll
            for (int c = 0; c < GCH; ++c) { bgp[c * 64 + tid] = acc; acc += BLO[((row0 >> 6) + c) * 256 + h * 64 + tid]; } }
    }
#pragma unroll
    for (int i = 0; i < 8; ++i) { char* d_ = lds + GF_TL + (tr + 32 * i) * GF_TLP + tc * 2; *(u32x2*)d_ = (u32x2){tl[i].x, tl[i].y}; *(u32x2*)(d_ + 8) = (u32x2){tl[i].z, tl[i].w}; }
#pragma unroll
    for (int i = 0; i < 8; ++i) tl[i] = *(const u32x4*)(CZ + (row0 + tr + 32 * i) * 512 + h * 128 + tc);
    __syncthreads();
    if (g > 0) {
        { const int t = tid >> 1, c0 = (tid & 1) * 32; const float* bgp = (const float*)(lds + GF_BG) + (t >> 6) * 64 + c0;
          const bf16_t* qp = QTO + (row0 + t) * 256 + h * 64 + c0;
#pragma unroll
          for (int j = 0; j < 4; ++j) { float qf_[8]; unpack8(*(const u32x4*)(qp + 8 * j), qf_);
              const f32x4 b0 = *(const f32x4*)(bgp + 8 * j), b1 = *(const f32x4*)(bgp + 8 * j + 4);
              qf_[0] *= __builtin_amdgcn_exp2f(b0.x); qf_[1] *= __builtin_amdgcn_exp2f(b0.y); qf_[2] *= __builtin_amdgcn_exp2f(b0.z); qf_[3] *= __builtin_amdgcn_exp2f(b0.w);
              qf_[4] *= __builtin_amdgcn_exp2f(b1.x); qf_[5] *= __builtin_amdgcn_exp2f(b1.y); qf_[6] *= __builtin_amdgcn_exp2f(b1.z); qf_[7] *= __builtin_amdgcn_exp2f(b1.w);
              *(u32x4*)(lds + GF_QH + t * 144 + (c0 + 8 * j) * 2) = pack8(qf_); } }
        __syncthreads();
#pragma unroll
        for (int ks = 0; ks < 4; ++ks) { const bf16x8 qf = *(const bf16x8*)(lds + GF_QH + (32 * wid + r32) * 144 + (16 * ks + 8 * hi) * 2);
#pragma unroll
            for (int blk = 0; blk < 4; ++blk) { const bf16x8 sf = *(const bf16x8*)(lds + GF_ST + (32 * blk + r32) * 144 + (16 * ks + 8 * hi) * 2);
                o[blk] = __builtin_amdgcn_mfma_f32_32x32x16_bf16(sf, qf, o[blk], 0, 0, 0); } }
    }
    char* myrow = lds + GF_TL + (32 * wid + r32) * GF_TLP + 8 * hi;
    float ss = 0.f;
#pragma unroll
    for (int blk = 0; blk < 4; ++blk)
#pragma unroll
        for (int q = 0; q < 4; ++q) { const u32x2 w = *(const u32x2*)(myrow + 64 * blk + 16 * q);
            o[blk][4 * q] += bf_lo(w.x); o[blk][4 * q + 1] += bf_hi(w.x); o[blk][4 * q + 2] += bf_lo(w.y); o[blk][4 * q + 3] += bf_hi(w.y);
            ss += (o[blk][4 * q] * o[blk][4 * q] + o[blk][4 * q + 1] * o[blk][4 * q + 1]) + (o[blk][4 * q + 2] * o[blk][4 * q + 2] + o[blk][4 * q + 3] * o[blk][4 * q + 3]); }
    ss = sum_x32(ss);
    const float rs = 1.0f / sqrtf(ss * (1.0f / 128.0f) + EPS);
    __syncthreads();
#pragma unroll
    for (int i = 0; i < 8; ++i) { char* d_ = lds + GF_TL + (tr + 32 * i) * GF_TLP + tc * 2; *(u32x2*)d_ = (u32x2){tl[i].x, tl[i].y}; *(u32x2*)(d_ + 8) = (u32x2){tl[i].z, tl[i].w}; }
    __syncthreads();
#pragma unroll
    for (int blk = 0; blk < 4; ++blk)
#pragma unroll
        for (int q = 0; q < 4; ++q) { u32x2* zp = (u32x2*)(myrow + 64 * blk + 16 * q); const u32x2 zw = *zp; const f32x4 gv = *(const f32x4*)(ong + 32 * blk + 8 * q + 4 * hi);
            u32x2 yw; yw.x = pk2(o[blk][4 * q] * rs * gv.x * bf_lo(zw.x), o[blk][4 * q + 1] * rs * gv.y * bf_hi(zw.x)); yw.y = pk2(o[blk][4 * q + 2] * rs * gv.z * bf_lo(zw.y), o[blk][4 * q + 3] * rs * gv.w * bf_hi(zw.y));
            *zp = yw; }
    __syncthreads();
#pragma unroll
    for (int i = 0; i < 8; ++i) { const char* s_ = lds + GF_TL + (tr + 32 * i) * GF_TLP + tc * 2; const u32x2 a_ = *(const u32x2*)s_, b_ = *(const u32x2*)(s_ + 8);
        *(u32x4*)(YOUT + (row0 + tr + 32 * i) * 512 + h * 128 + tc) = (u32x4){a_.x, a_.y, b_.x, b_.y}; }
    __syncthreads();
}
#undef KSWZ
#undef SBAR
}

struct Args { const float* in[18]; float* out; unsigned char* ws; int ph_lo, ph_hi; };
constexpr int TQ_WORD = 3584;
enum { I_X = 0, I_NORMG, I_WIN, I_ALNG, I_ALNB, I_ASW, I_ASB, I_BQG, I_BKG, I_CW2, I_CB, I_CONG, I_DCW, I_DCB, I_WBO, I_WMG, I_BMG, I_WOUT };

__device__ __forceinline__ void transpose_item(const float* W, int ldw, int c0, int valid, int k0, bf16_t* dst  , int ldd, LAS float* scr, int lane, float scale = 1.0f) {
#pragma unroll 8
    for (int i = 0; i < 32; ++i) { const int kk = 2 * i + (lane >> 5), n = lane & 31; scr[kk * 33 + n] = (n < valid) ? W[(size_t)(k0 + kk) * ldw + c0 + n] * scale : 0.f; }
    asm volatile("s_waitcnt lgkmcnt(0)" ::: "memory");
    const int c = lane & 7;
#pragma unroll
    for (int j = 0; j < 4; ++j) { const int n = (lane >> 3) + 8 * j; const LAS float* s = scr + (8 * c) * 33 + n;
        u32x4 o; o.x = pk2(s[0 * 33], s[1 * 33]); o.y = pk2(s[2 * 33], s[3 * 33]); o.z = pk2(s[4 * 33], s[5 * 33]); o.w = pk2(s[6 * 33], s[7 * 33]);
        *(u32x4*)(dst + (size_t)n * ldd + 8 * c) = o; }
    asm volatile("s_waitcnt lgkmcnt(0)" ::: "memory");
}
__device__ __forceinline__ void cat_src(int tile, int half, int& mat, int& col, int& valid) {
    mat = 0; valid = 128;
    if (tile < 4) col = half == 0 ? A_OFF + 128 * tile : A_OFF + 1024 + 128 * tile;
    else if (tile < 6) col = A_OFF + 512 + 256 * (tile - 4) + 128 * half;
    else if (tile < 14) col = B_OFF + 256 * (tile - 6) + 128 * half;
    else if (tile < 16) col = C_OFF + 256 * (tile - 14) + 128 * half;
    else if (tile < 18) col = C_OFF + 512 + 256 * (tile - 16) + 128 * half;
    else if (tile < 20) col = C_OFF + 1040 + 256 * (tile - 18) + 128 * half;
    else if (tile < 24) col = half == 0 ? D_OFF + 512 + 128 * (tile - 20) : D_OFF + 1024 + 128 * (tile - 20);
    else if (tile < 28) col = half == 0 ? D_OFF + 128 * (tile - 24) : D_OFF + 1536 + 128 * (tile - 24);
    else { const int q = tile - 28; mat = 1 + (q >> 2); col = 256 * (q & 3) + 128 * half; }
}
__device__ __forceinline__ void phase_prologue(const Args& a, LAS unsigned char* lds, int wave, int lane) {
    LAS float* scr = (LAS float*)(lds + wave * 16384);
    const int gw = blockIdx.x * NWAVES + wave, NGW = gridDim.x * NWAVES;
    constexpr int I_CAT = (NCAT / 32) * 16, I_BO = (4096 / 32) * 8, I_OUT = (1024 / 32) * 16, I_LAYER = I_CAT + I_BO + I_OUT;
    for (int it = gw; it < DEPTH * I_LAYER; it += NGW) {
        const int l = it / I_LAYER; int r = it % I_LAYER;
        unsigned char* wl = a.ws + OFF_W + (size_t)l * W_LAYER_BYTES;
        if (r < I_CAT) {
            const int nb = r >> 4, kb = r & 15, n0 = nb * 32, tile = n0 >> 8, half = (n0 >> 7) & 1, off = n0 & 127;
            int mat, col, valid; cat_src(tile, half, mat, col, valid);
            if (mat != 0) {
                const float* W = a.in[I_WMG] + (size_t)(l * 4 + mat - 1) * 1024 * 1024 + (size_t)(kb * 64 + (lane >> 5)) * 1024 + col + off + (lane & 31);
                float mx = 0.f;
#pragma unroll 8
                for (int i = 0; i < 32; ++i) mx = fmaxf(mx, fabsf(W[(size_t)i * 2048]));
                { auto r2 = __builtin_amdgcn_permlane32_swap(__float_as_uint(mx), __float_as_uint(mx), false, false); mx = fmaxf(__uint_as_float(r2[0]), __uint_as_float(r2[1])); }
                if (lane < 32) atomicMax((unsigned*)(a.ws + OFF_AMAX) + l * 4096 + (n0 - 7168) + lane, __float_as_uint(mx));
                continue;
            }
            int v = valid - off; v = v < 0 ? 0 : (v > 32 ? 32 : v);
            const float* W; int ldw;
            if (mat == 0) { W = a.in[I_WIN] + (size_t)l * 1024 * NIN; ldw = NIN; } else { W = a.in[I_WMG] + (size_t)(l * 4 + mat - 1) * 1024 * 1024; ldw = 1024; }
            transpose_item(W, ldw, col + off, v, kb * 64, (bf16_t*)(wl + WOFF_CAT) + (size_t)n0 * 1024 + kb * 64, 1024, scr, lane);
            continue;
        }
        r -= I_CAT;
        if (r < I_BO) {
            const int nb = r >> 3, kb = r & 7, n0 = nb * 32, br = n0 >> 10, nn = n0 & 1023;
            const float* W = a.in[I_WBO] + (size_t)(l * 4 + br) * 512 * 1024;
            transpose_item(W, 1024, nn, 32, kb * 64, (bf16_t*)(wl + WOFF_BO) + (size_t)n0 * 512 + kb * 64, 512, scr, lane, 1.0f / 255.0f);
            continue;
        }
        r -= I_BO;
        { const int nb = r >> 4, kb = r & 15, n0 = nb * 32;
          const float* W = a.in[I_WOUT] + (size_t)l * 1024 * 1024;
          transpose_item(W, 1024, n0, 32, kb * 64, (bf16_t*)(wl + WOFF_OUT) + (size_t)n0 * 1024 + kb * 64, 1024, scr, lane); }
    }
    for (int idx = gw * 64 + lane; idx < DEPTH * 1024 * 16; idx += NGW * 64) {
        const int l = idx >> 14, c = (idx >> 4) & 1023, r = idx & 15;
        ((float*)(a.ws + OFF_WLR))[(size_t)l * 20480 + (((c >> 8) * 4 + (c & 3)) * 64 + ((c >> 2) & 63)) * 20 + r] = a.in[I_WIN][(size_t)l * 1024 * NIN + (size_t)c * NIN + (C_OFF + 1024) + r];
    }
    for (int idx = gw * 64 + lane; idx < DEPTH * 4 * 128 * 16; idx += NGW * 64) {
        const int t = (idx >> 4) & 127, s0 = (idx & 15) * 8; const float* src = a.in[I_ASW] + (size_t)(idx >> 4) * 128 + s0; float f[8];
#pragma unroll
        for (int j = 0; j < 8; ++j) f[j] = (s0 + j <= t) ? src[j] : 0.f;
        *(u32x4*)((bf16_t*)(a.ws + OFF_WA) + (size_t)(idx >> 4) * 128 + s0) = pack8(f);
    }
}

__device__ __forceinline__ void phase_quant_gates(const Args& a, LAS unsigned char* lds, int wave, int lane) {
    LAS float* scr = (LAS float*)(lds + wave * 16384);
    if (blockIdx.x == 0 && wave < DEPTH) {
        const float gq = wave_max(fmaxf(fabsf(a.in[I_BQG][wave * 128 + lane]), fabsf(a.in[I_BQG][wave * 128 + 64 + lane])));
        const float gk = wave_max(fmaxf(fabsf(a.in[I_BKG][wave * 128 + lane]), fabsf(a.in[I_BKG][wave * 128 + 64 + lane])));
        const float b2 = 2.0f * 1.01f * 11.313708498984761f * gq * gk + 103.3f;
        if (lane < 4) { const float t = b2 * (lane == 0 ? 4.0f : lane == 1 ? 16.0f : lane == 2 ? 64.0f : 256.0f);
            ((int*)(a.ws + OFF_CTL))[TQ_WORD + wave * 4 + lane] = (int)fminf(t + 1.0f, 1048576.0f); }
    }
    const int gw = blockIdx.x * NWAVES + wave, NGW = gridDim.x * NWAVES;
    for (int it = gw; it < DEPTH * 128 * 16; it += NGW) {
        const int l = it >> 11, nb = (it >> 4) & 127, kb = it & 15, n0 = nb * 32;
        const float* W = a.in[I_WMG] + (size_t)(l * 4 + (n0 >> 10)) * 1024 * 1024 + (n0 & 1023);
#pragma unroll 8
        for (int i = 0; i < 32; ++i) { const int kk = 2 * i + (lane >> 5), n = lane & 31; scr[kk * 33 + n] = W[(size_t)(kb * 64 + kk) * 1024 + n]; }
        asm volatile("s_waitcnt lgkmcnt(0)" ::: "memory");
        const int c = lane & 3;
        unsigned char* dst = a.ws + OFF_W + (size_t)l * W_LAYER_BYTES + WOFF_G8 + (size_t)n0 * 1024 + kb * 64 + 16 * c;
#pragma unroll
        for (int j = 0; j < 2; ++j) { const int n = (lane >> 2) + 16 * j; const LAS float* s = scr + (16 * c) * 33 + n;
            const float q = 256.0f / fmaxf(__uint_as_float(((const unsigned*)(a.ws + OFF_AMAX))[l * 4096 + n0 + n]), 1e-30f);
            u32x4 o; o.x = pk4_fp8(s[0 * 33] * q, s[1 * 33] * q, s[2 * 33] * q, s[3 * 33] * q); o.y = pk4_fp8(s[4 * 33] * q, s[5 * 33] * q, s[6 * 33] * q, s[7 * 33] * q);
            o.z = pk4_fp8(s[8 * 33] * q, s[9 * 33] * q, s[10 * 33] * q, s[11 * 33] * q); o.w = pk4_fp8(s[12 * 33] * q, s[13 * 33] * q, s[14 * 33] * q, s[15 * 33] * q);
            *(u32x4*)(dst + (size_t)n * 1024) = o; }
        asm volatile("s_waitcnt lgkmcnt(0)" ::: "memory");
    }
}

__device__ __forceinline__ void phase_rmsnorm(const Args& a, int l, int hf, LAS unsigned char* lds, int tid, int wave, int lane) {
    const float* xs = (l == 0 ? a.in[I_X] : a.out) + (size_t)hf * MH * DM;
    bf16_t* H = (bf16_t*)(a.ws + OFF_H); float* LRF = (float*)(a.ws + OFF_LRF);
    { const f32x4* wsrc = (const f32x4*)(a.ws + OFF_WLR) + (size_t)l * 5120;
#pragma unroll
      for (int i = 0; i < 10; ++i) *(LAS f32x4*)(lds + (size_t)(tid + i * NTHREADS) * 16) = wsrc[tid + i * NTHREADS]; }
    __syncthreads();
    const f32x4* gp = (const f32x4*)(a.in[I_NORMG] + l * DM) + lane;
    f32x4 g[4];
#pragma unroll
    for (int j = 0; j < 4; ++j) g[j] = gp[64 * j];
    const int gw = blockIdx.x * NWAVES + wave, NGW = gridDim.x * NWAVES;
    const bool hi5 = (lane & 32) != 0, hi4 = (lane & 16) != 0, hi3 = (lane & 8) != 0, hi2 = (lane & 4) != 0;
    f32x4 vn[4];
    { const f32x4* xr0 = (const f32x4*)(xs + (size_t)(gw < MH ? gw : 0) * DM) + lane;
#pragma unroll
      for (int j = 0; j < 4; ++j) vn[j] = xr0[64 * j]; }
    for (int m = gw; m < MH; m += NGW) {
        f32x4 v[4]; float s = 0.f;
#pragma unroll
        for (int j = 0; j < 4; ++j) v[j] = vn[j];
        { const int mn = (m + NGW < MH) ? m + NGW : m; const f32x4* xr = (const f32x4*)(xs + (size_t)mn * DM) + lane;
#pragma unroll
          for (int j = 0; j < 4; ++j) vn[j] = xr[64 * j]; }
#pragma unroll
        for (int j = 0; j < 4; ++j) s += (v[j].x * v[j].x + v[j].y * v[j].y) + (v[j].z * v[j].z + v[j].w * v[j].w);
        const float r = 1.0f / sqrtf(wave_sum(s) * (1.0f / DM) + EPS);
        u32x2* o = (u32x2*)(H + (size_t)m * DM) + lane;
        { float mx = 0.f;
#pragma unroll
          for (int j = 0; j < 4; ++j) mx = fmaxf(fmaxf(mx, fmaxf(fabsf(v[j].x * g[j].x), fabsf(v[j].y * g[j].y))), fmaxf(fabsf(v[j].z * g[j].z), fabsf(v[j].w * g[j].w)));
          mx = fmaxf(wave_max(mx), 1e-30f); const float q = 256.0f / mx;
          unsigned* o8 = (unsigned*)(a.ws + OFF_H8 + (size_t)m * DM) + lane;
#pragma unroll
          for (int j = 0; j < 4; ++j) o8[64 * j] = pk4_fp8(v[j].x * g[j].x * q, v[j].y * g[j].y * q, v[j].z * g[j].z * q, v[j].w * g[j].w * q);
          if (lane == 0) ((float*)(a.ws + OFF_RS))[m] = r * mx * (1.0f / 256.0f); }
        float p[16];
#pragma unroll
        for (int i = 0; i < 16; ++i) p[i] = 0.f;
        int lw = lane * 20; asm volatile("" : "+v"(lw));
#pragma unroll
        for (int j = 0; j < 4; ++j) { const f32x4 hv = {v[j].x * r * g[j].x, v[j].y * r * g[j].y, v[j].z * r * g[j].z, v[j].w * r * g[j].w};
            u32x2 w; w.x = pk2(hv.x, hv.y); w.y = pk2(hv.z, hv.w); o[64 * j] = w;
#pragma unroll
            for (int e = 0; e < 4; ++e) { const LAS float* wp = (const LAS float*)lds + (j * 4 + e) * 64 * 20 + lw; const float hh = hv[e];
#pragma unroll
                for (int q = 0; q < 4; ++q) { const f32x4 w4 = *(const LAS f32x4*)(wp + 4 * q); p[4 * q] += hh * w4.x; p[4 * q + 1] += hh * w4.y; p[4 * q + 2] += hh * w4.z; p[4 * q + 3] += hh * w4.w; } } }
        float q8[8], q4[4], q2[2], q1;
#pragma unroll
        for (int i = 0; i < 8; ++i) { const float snd = hi5 ? p[i] : p[i + 8], kp = hi5 ? p[i + 8] : p[i]; q8[i] = kp + xchg32(snd, hi5); }
#pragma unroll
        for (int i = 0; i < 4; ++i) { const float snd = hi4 ? q8[i] : q8[i + 4], kp = hi4 ? q8[i + 4] : q8[i]; q4[i] = kp + xchg16(snd, hi4); }
#pragma unroll
        for (int i = 0; i < 2; ++i) { const float snd = hi3 ? q4[i] : q4[i + 2], kp = hi3 ? q4[i + 2] : q4[i]; q2[i] = kp + dpp_f(snd, DPP_ROR8); }
        { const float snd = hi2 ? q2[0] : q2[1], kp = hi2 ? q2[1] : q2[0]; q1 = kp + swz_x4(snd); }
        q1 += dpp_f(q1, DPP_QX1); q1 += dpp_f(q1, DPP_QX2);
        if ((lane & 3) == 0) LRF[(size_t)m * 16 + (hi5 ? 8 : 0) + (hi4 ? 4 : 0) + (hi3 ? 2 : 0) + (hi2 ? 1 : 0)] = q1;
    }
    __syncthreads();
}

__device__ __forceinline__ void mixer_b_prep(const Args& a, int l, int unit, LAS unsigned char* lds, int tid, int wave, int lane) {
    (void)tid;
    bf16_t* PB = (bf16_t*)(a.ws + OFF_PB); float* KM = (float*)(a.ws + OFF_KMEAN);
    const int blkid = unit >> 1, hp = unit & 1;
    const int r0 = (blkid >> 4) * SEQ + (blkid & 15) * 256, l32 = lane & 31, up = lane >> 5;
    float gq[8], gk[8], ks[8];
#pragma unroll
    for (int j = 0; j < 8; ++j) { gq[j] = a.in[I_BQG][l * 128 + (l32 & 15) * 8 + j]; gk[j] = a.in[I_BKG][l * 128 + (l32 & 15) * 8 + j]; ks[j] = 0.f; }
    for (int i0 = 0; i0 < 32; i0 += 16) {
        u32x4 rq[8], rk[8];
#pragma unroll
        for (int u = 0; u < 8; ++u) { const bf16_t* rp = PB + (size_t)(r0 + wave * 32 + i0 + 2 * u + up) * 2048 + hp * 256 + l32 * 8; rq[u] = *(const u32x4*)rp; rk[u] = *(const u32x4*)(rp + 512); }
#pragma unroll
        for (int u = 0; u < 8; ++u) {
            bf16_t* rp = PB + (size_t)(r0 + wave * 32 + i0 + 2 * u + up) * 2048 + hp * 256 + l32 * 8;
            { float f[8]; unpack8(rq[u], f); float ss = 0.f;
#pragma unroll
              for (int j = 0; j < 8; ++j) ss += f[j] * f[j];
              ss = row16_sum(ss);
              const float r = 1.0f / sqrtf(ss * (1.0f / 128.0f) + EPS);
#pragma unroll
              for (int j = 0; j < 8; ++j) f[j] = f[j] * r * gq[j];
              *(u32x4*)rp = pack8(f); }
            { float f[8]; unpack8(rk[u], f); float ss = 0.f;
#pragma unroll
              for (int j = 0; j < 8; ++j) ss += f[j] * f[j];
              ss = row16_sum(ss);
              const float r = 1.0f / sqrtf(ss * (1.0f / 128.0f) + EPS);
#pragma unroll
              for (int j = 0; j < 8; ++j) { f[j] = f[j] * r * gk[j]; ks[j] += f[j]; }
              *(u32x4*)(rp + 512) = pack8(f); }
        }
    }
    LAS float* red = (LAS float*)lds;
#pragma unroll
    for (int j = 0; j < 8; ++j) { const float t_ = sum_x32(ks[j]); if (up == 0) red[wave * 256 + l32 * 8 + j] = t_; }
    __syncthreads();
    if (tid < 256) { float s_ = 0.f;
#pragma unroll
        for (int w = 0; w < 8; ++w) s_ += red[w * 256 + tid];
        KM[(size_t)blkid * 512 + hp * 256 + tid] = s_ * (1.0f / 256.0f); }
    __syncthreads();
}
__device__ __forceinline__ void mixer_d_conv(const Args& a, int l, int tid) {
    const bf16_t* DCX = (const bf16_t*)(a.ws + OFF_DCX); const bf16_t* DBZ = (const bf16_t*)(a.ws + OFF_DBZ); bf16_t* DOUT = (bf16_t*)(a.ws + OFF_YD);
    const int gt = blockIdx.x * NTHREADS + tid, GT = gridDim.x * NTHREADS;
    const float* cw = a.in[I_DCW] + (size_t)l * 3 * BW; const float* cb = a.in[I_DCB] + (size_t)l * BW;
    const int cv = (tid & 63) * 8;
    float w0[8], w1[8], w2[8], bb[8];
#pragma unroll
    for (int j = 0; j < 8; ++j) { w0[j] = cw[cv + j]; w1[j] = cw[BW + cv + j]; w2[j] = cw[2 * BW + cv + j]; bb[j] = cb[cv + j]; }
    constexpr int RUN = 8;
    for (int rb = gt >> 6; rb < MH / RUN; rb += GT >> 6) {
        const int row0 = rb * RUN, t0 = row0 & (SEQ - 1);
        float x1[8], x2[8];
        if (t0 >= 2) { unpack8(*(const u32x4*)(DCX + (size_t)(row0 - 1) * 512 + cv), x1); unpack8(*(const u32x4*)(DCX + (size_t)(row0 - 2) * 512 + cv), x2); }
        else {
#pragma unroll
            for (int j = 0; j < 8; ++j) { x1[j] = 0.f; x2[j] = 0.f; } }
        u32x4 xr[RUN], br[RUN];
#pragma unroll
        for (int i = 0; i < RUN; ++i) { xr[i] = *(const u32x4*)(DCX + (size_t)(row0 + i) * 512 + cv); br[i] = *(const u32x4*)(DBZ + (size_t)(row0 + i) * 512 + cv); }
#pragma unroll
        for (int i = 0; i < RUN; ++i) { float x0[8], bz[8], y[8]; unpack8(xr[i], x0); unpack8(br[i], bz);
#pragma unroll
            for (int j = 0; j < 8; ++j) { y[j] = bz[j] * (w0[j] * x2[j] + w1[j] * x1[j] + w2[j] * x0[j] + bb[j]); x2[j] = x1[j]; x1[j] = x0[j]; }
            *(u32x4*)(DOUT + (size_t)(row0 + i) * 512 + cv) = pack8(y); }
    }
}


constexpr int ATT_C1 = 8, ATT_C2 = 31, ATT_C3 = 43;
__device__ const unsigned ATT_TAB[64] = {0x88au, 0x94du, 0xa10u, 0xad3u, 0xb96u, 0x1d9u, 0x11cu, 0x5fu, 0x30u, 0x2fu, 0x2du, 0x2cu, 0x2au, 0x29u, 0x13u, 0x27u, 0x26u, 0x24u, 0x23u, 0x10u, 0x21u, 0x20u, 0x1eu, 0x1du, 0xdu, 0x1bu, 0x1au, 0x18u, 0x17u, 0x4au, 0x107u, 0x1cu, 0x1fu, 0x22u, 0x25u, 0x28u, 0x2bu, 0x2eu, 0x19u, 0x56u, 0x113u, 0x1d0u, 0x28du, 0x30u, 0x2fu, 0x2du, 0x2cu, 0x2au, 0x29u, 0x13u, 0x27u, 0x26u, 0x24u, 0x23u, 0x10u, 0x21u, 0x20u, 0x1eu, 0x1du, 0xdu, 0x5bu, 0x11au, 0x1d8u, 0x297u};
__device__ const unsigned Z_TAB[64] = {0x15u, 0x22u, 0x23u, 0x24u, 0x25u, 0x29u, 0x2du, 0x3fu, 0x35u, 0x33u, 0x39u, 0x37u, 0x26u, 0x18u, 0x9u, 0x3du, 0x3bu, 0x2cu, 0x1cu, 0x1au, 0x108cu, 0x8au, 0xa3eu, 0x92fu, 0x220u, 0x141eu, 0x1390u, 0xb0fu, 0x38eu, 0x1du, 0x2au, 0x0u, 0x0u, 0x0u, 0x0u, 0x0u, 0x0u, 0x0u, 0x0u, 0x0u, 0x0u, 0x0u, 0x0u, 0x34u, 0x32u, 0x38u, 0x36u, 0x19u, 0x17u, 0x8u, 0x3cu, 0x3au, 0x2bu, 0x1bu, 0xdu, 0x88bu, 0x40u, 0x9b0u, 0x2aeu, 0x19fu, 0x6u, 0x2u, 0x31u, 0x0u};
__device__ __forceinline__ moba::BlockRef moba_ref(const Args& a, int bh, int code, int pass, int tq) {
    const int qb = (code - 1) / 3, part = (code - 1) % 3, bl = bh >> 2, h = bh & 3;
    const bf16_t* PB = (const bf16_t*)(a.ws + OFF_PB); const size_t rb = (size_t)bl * SEQ, r0 = rb + (size_t)qb * 256;
    moba::BlockRef r;
    r.Q = PB + r0 * 2048 + h * 128; r.K = PB + rb * 2048 + 512 + h * 128; r.V = PB + rb * 2048 + 1024 + h * 128; r.Z = PB + r0 * 2048 + 1536 + h * 128;
    r.O = (bf16_t*)(a.ws + OFF_YB) + r0 * 512 + h * 128; r.KM = (const float*)(a.ws + OFF_KMEAN) + (size_t)(bl * 64 + h) * 128; r.qb = qb;
    r.slopeR = (h == 0 ? 0.25f : h == 1 ? 0.0625f : h == 2 ? 0.015625f : 0.00390625f) * 11.313708498984761f;
    const int nt = 4 * (qb + 1);
    { const int j0 = part == 2 ? nt / 2 : 0, jend = j0 + (part == 0 ? nt : nt / 2);
      const int jm = max(0, (256 * qb - tq) >> 6) & ~1;
      const int jl = max(j0, min(jm, jend - 4));
      r.jlo = jl; r.ntp = jend - jl; }
    const int su = bh * 12 + (qb - 4);
    r.part = part ? (float*)(a.ws + OFF_ATTP) + (size_t)su * 66 * 512 : nullptr;
    r.cnt = part ? (unsigned*)(a.ws + OFF_CTL) + 4096 + (pass * 192 + su) * 2 : nullptr;
    return r;
}
__device__ __forceinline__ void mixer_b_attn(const Args& a, char* lds, int wave_in, int G, int bid, int pass, int l, size_t off_yc) {
    for (int v = bid; v < 256; v += G) {
        const int tid = opaque_s(wave_in) * 64 + opaque_lane();
        const int xcd = v & 7, k = v >> 3, slot = 32 * (xcd & 1) + k, bh = (xcd >> 1) * 4 + (slot >= ATT_C3 ? 2 : slot >= ATT_C2 ? 1 : slot >= ATT_C1 ? 3 : 0);
        const int tq = __builtin_amdgcn_readfirstlane((int)__hip_atomic_load((unsigned*)(a.ws + OFF_CTL) + TQ_WORD + (l & (DEPTH - 1)) * 4 + (bh & 3), __ATOMIC_RELAXED, __HIP_MEMORY_SCOPE_AGENT));
        const unsigned codes = ATT_TAB[slot];
        int ci = 0; int code = (int)(codes & 63u);
        moba::BlockRef cur = moba_ref(a, bh, code, pass, tq); moba::Seam S;
        { const f32x4 kmv = *(const f32x4*)(cur.KM + (tid >> 5) * 512 + (tid & 31) * 4);
          *(f32x4*)(lds + moba::OFF_KMT + ((tid >> 5) * moba::KMT_LD + (tid & 31) * 4) * 4) = kmv; }
        moba::prime(cur, lds, S, tid);
        for (;;) {
            const unsigned sel = moba::select_blocks(S, (const float*)(lds + moba::OFF_KMT), cur.qb, (tid >> 5) & 1, tid & 31);
            const int ncode = (int)((codes >> (6 * (ci + 1))) & 63u); const bool last = ncode == 0;
            const int nqb = last ? cur.qb : (ncode - 1) / 3, npart = last ? 0 : (ncode - 1) % 3, nnt = 4 * (nqb + 1);
            const int nlast = last ? cur.jlo + cur.ntp - 1 : (npart == 2 ? nnt / 2 : 0) + (npart == 0 ? nnt : nnt / 2) - 1;
            moba::block(cur, cur.Q + (ptrdiff_t)(nqb - cur.qb) * 256 * 2048, nlast, sel, lds, S, tid);
            if (last) break;
            cur = moba_ref(a, bh, ncode, pass, tq); ++ci;
        }
        unsigned zm = (PROBE_REP == 14 && pass >= 4) ? 0u : Z_TAB[slot];
        while (zm) { const int zc = (int)(zm & 127u) - 1, g = zc & 15; zm >>= 7;
            const int tz = opaque_s(wave_in) * 64 + opaque_lane();
            moba::gla_fix((const bf16_t*)(a.ws + OFF_OL), (const bf16_t*)(a.ws + OFF_QTO), (const float*)(a.ws + OFF_BLO), (const float*)(a.ws + OFF_TT), (const float*)(a.ws + OFF_DGO), (const bf16_t*)(a.ws + OFF_CZ), (bf16_t*)(a.ws + off_yc), a.in[I_CONG] + l * 128, bh >> 2, zc >> 4, g, lds, tz); }
    }
}

#define XB_TMO      128
#define XB_XCNT(j)  (256  + 64 * (j))
#define XB_XSUB(j)  (1280 + 64 * (j))
#define XB_XGEN(j)  (2304 + 64 * (j))
#define XB_TOP      3328
#define XB_TOPGEN   3392
#define XCD_BAR_WORDS 3456
#define XB_SPIN_CAP (1u << 18)
__device__ __forceinline__ unsigned xb_ld(unsigned* p)              { return __hip_atomic_load(p, __ATOMIC_RELAXED, __HIP_MEMORY_SCOPE_AGENT); }
__device__ __forceinline__ unsigned xb_add(unsigned* p, unsigned v) { return __hip_atomic_fetch_add(p, v, __ATOMIC_RELAXED, __HIP_MEMORY_SCOPE_AGENT); }
__device__ __forceinline__ unsigned xb_xcc_id() { return (unsigned)__builtin_amdgcn_s_getreg((3 << 11) | 20) & 0xFu; }
#define XB_SPIN(cond, bar) do { unsigned _sp = 0; while (cond) { __builtin_amdgcn_s_sleep(1); \
    if ((++_sp & 255u) == 0u) { if (xb_ld(&(bar)[XB_TMO])) break; if (_sp > XB_SPIN_CAP) { atomicAdd(&(bar)[XB_TMO], 1u); break; } } } } while (0)
struct XcdBarrier { unsigned* bar; unsigned x; volatile LAS unsigned* st; };
__device__ __forceinline__ XcdBarrier xcd_barrier_post(unsigned* bar, volatile LAS unsigned* st) {
    XcdBarrier b; b.bar = bar; b.x = xb_xcc_id(); b.st = st;
    if (threadIdx.x == 0) (void)xb_add(&bar[XB_XCNT(b.x)], 1u);
    return b;
}
__device__ __forceinline__ void xcd_barrier_complete(unsigned* bar, unsigned x, unsigned& nloc, unsigned& nx) {
    const unsigned G = gridDim.x * gridDim.y * gridDim.z;
    unsigned sum, cnt, mine, sp = 0u;
    for (;;) {
        sum = 0u; cnt = 0u; mine = 0u;
#pragma unroll
        for (unsigned j = 0; j < 16; ++j) { const unsigned c = xb_ld(&bar[XB_XCNT(j)]); sum += c; cnt += (c > 0u) ? 1u : 0u; mine = (j == x) ? c : mine; }
        if (sum == G) break;
        __builtin_amdgcn_s_sleep(1);
        if ((++sp & 255u) == 0u) { if (xb_ld(&bar[XB_TMO])) break; if (sp > XB_SPIN_CAP) { atomicAdd(&bar[XB_TMO], 1u); break; } }
    }
    nloc = mine > 0u ? mine : 1u; nx = cnt > 0u ? cnt : 1u;
}
__device__ __forceinline__ void xcd_barrier(const XcdBarrier& b) {
    asm volatile("s_waitcnt vmcnt(0)" ::: "memory");
    __syncthreads();
    if (threadIdx.x == 0) {
        unsigned* bar = b.bar;
        __builtin_amdgcn_s_waitcnt(0);
        unsigned nloc = b.st[0], nx = b.st[1];
        if (nloc == 0u) { xcd_barrier_complete(bar, b.x, nloc, nx); b.st[0] = nloc; b.st[1] = nx; }
        const unsigned old = xb_add(&bar[XB_XSUB(b.x)], 1u);
        const unsigned gen = old / nloc;
        if (old + 1u == (gen + 1u) * nloc) {
            __builtin_amdgcn_fence(__ATOMIC_RELEASE, "agent");
            asm volatile("s_waitcnt vmcnt(0)" ::: "memory");
            const unsigned og = xb_add(&bar[XB_TOP], 1u);
            const unsigned tg = og / nx;
            if (og + 1u == (tg + 1u) * nx) xb_add(&bar[XB_TOPGEN], 1u);
            else XB_SPIN(xb_ld(&bar[XB_TOPGEN]) == tg, bar);
            xb_add(&bar[XB_XGEN(b.x)], 1u);
            __builtin_amdgcn_fence(__ATOMIC_ACQUIRE, "agent");
            asm volatile("s_waitcnt vmcnt(0)" ::: "memory");
        } else {
            XB_SPIN(xb_ld(&bar[XB_XGEN(b.x)]) == gen, bar);
            __builtin_amdgcn_fence(__ATOMIC_ACQUIRE, "agent");
            asm volatile("s_waitcnt vmcnt(0)" ::: "memory");
        }
    }
    __syncthreads();
}

constexpr int PH_PER_PASS = 6 + ((PROBE_REP >= 0 && PROBE_REP != 9 && PROBE_REP < 20) ? 1 : 0), N_PRO = (PROBE_REP == 9 ? 2 : 1), N_PHASES = N_PRO + DEPTH * NSPLIT * PH_PER_PASS;
__device__ __forceinline__ int slot_kind(int slot) {
    if (PROBE_REP < 0 || PROBE_REP == 9 || PROBE_REP >= 20) return slot;
    if (PROBE_REP == 3) return slot < 3 ? slot : (slot == 3 ? 6 : slot - 1);
    if (PROBE_REP == 10) return slot < 2 ? slot : (slot == 2 ? 10 : slot - 1);
    if (PROBE_REP == 11 || (PROBE_REP >= 16 && PROBE_REP <= 18)) return slot <= 2 ? slot : slot - 1;
    if (PROBE_REP == 12 || PROBE_REP == 14) return slot < 3 ? slot : (slot == 3 ? 12 : slot - 1);
    if (PROBE_REP == 13) return slot < 2 ? slot : (slot == 2 ? 13 : slot - 1);
    return slot <= PROBE_REP ? slot : slot - 1;
}
typedef const __attribute__((address_space(4))) Args* KArgs;
__device__ __forceinline__ Args ld_args(KArgs kp) { asm volatile("" : "+s"(kp)); Args r;
#pragma unroll
    for (int i = 0; i < 18; ++i) r.in[i] = kp->in[i];
    r.out = kp->out; r.ws = kp->ws; r.ph_lo = kp->ph_lo; r.ph_hi = kp->ph_hi; return r; }
#define PHASE_ARGS const Args a = ld_args(kp); const int wave = opaque_s(wave0), lane = opaque_lane(), tid = wave * 64 + lane, bid = opaque_s(bid0), G = opaque_s(G0)
__global__ void __launch_bounds__(NTHREADS, 2) fwd_kernel(Args a_) {
    extern __shared__ __attribute__((aligned(16))) unsigned char lds_raw[];
    LAS unsigned char* lds = (LAS unsigned char*)lds_raw;
    const int G0 = gridDim.x, bid0 = blockIdx.x, wave0 = __builtin_amdgcn_readfirstlane(threadIdx.x >> 6);
    KArgs kp = (KArgs)__builtin_amdgcn_kernarg_segment_ptr();
    const int ph_lo = a_.ph_lo, ph_hi = a_.ph_hi;
    volatile LAS unsigned* bst = (volatile LAS unsigned*)(lds + 147456);
    if (threadIdx.x < 16) bst[threadIdx.x] = 0u;
    __syncthreads();
    XcdBarrier gbar; gbar.bar = (unsigned*)(a_.ws + OFF_CTL); gbar.x = 0; gbar.st = bst;
    if (ph_hi - ph_lo > 1) gbar = xcd_barrier_post((unsigned*)(a_.ws + OFF_CTL), bst);
    for (int ph = ph_lo; ph < ph_hi; ++ph) {
        if (ph < N_PRO) { PHASE_ARGS; phase_prologue(a, lds, wave, lane);
        }
        else {
            const int p = ph - N_PRO, l = p / (NSPLIT * PH_PER_PASS), hf = (p / PH_PER_PASS) % NSPLIT, s = slot_kind(p % PH_PER_PASS);
            if (MERGE_S0 && PROBE_REP != 0 && s == 0 && (l | hf) != 0) continue;
            if (s == 0) { PHASE_ARGS; if ((l | hf) == 0) { phase_quant_gates(a, lds, wave, lane); __syncthreads(); } phase_rmsnorm(a, l, hf, lds, tid, wave, lane); }
            else if (s == 1) {
                PHASE_ARGS; (void)lane; unsigned char* wl = a.ws + OFF_W + (size_t)l * W_LAYER_BYTES;
                { SchedTiles S; S.so.init(MH, 7168, G, bid); S.A = (const char*)(a.ws + OFF_H); S.B = (const char*)(wl + WOFF_CAT); S.tA = (size_t)256 * 1024 * 2; S.tB = (size_t)256 * 1024 * 2;
                  EpiP1 E{a.ws, lds + 131072};
                  pg8::gemm_phase<EpiP1, SchedTiles, true>(lds, tid, 1024, 1024, 1024, S, E); }
                { SchedTiles S; S.so.init(MH, 4096, G, bid); S.A = (const char*)(a.ws + OFF_H8); S.B = (const char*)(wl + WOFF_G8); S.tA = (size_t)256 * 1024; S.tB = (size_t)256 * 1024;
                  EpiG E{(bf16_t*)(a.ws + OFF_G), a.in[I_BMG] + (size_t)l * 4096, (const unsigned*)(a.ws + OFF_AMAX) + l * 4096, (const float*)(a.ws + OFF_RS)};
                  pg8::gemm_phase<EpiG, SchedTiles, true, true>(lds, opaque_s(wave) * 64 + opaque_lane(), 512, 512, 512, S, E); }
            } else if (s == 2) {
                PHASE_ARGS; const bool xtra = (PROBE_REP >= 16 && PROBE_REP <= 18) && (p % PH_PER_PASS) == 3; const bool do_gl = !xtra || PROBE_REP == 16, do_ab = !xtra || PROBE_REP == 17, do_d = !xtra || PROBE_REP == 18;
                if (do_gl) for (int u = bid; u < BPH * 4 * moba::NGRP; u += G) { const int sq = u / moba::NGRP, g = u % moba::NGRP;
                    moba::gla_local((const bf16_t*)(a.ws + OFF_CQK), (const bf16_t*)(a.ws + OFF_CV), (const float*)(a.ws + OFF_LRF), a.in[I_CW2] + (size_t)l * 16 * 256, a.in[I_CB] + (size_t)l * 256, (bf16_t*)(a.ws + OFF_OL), (bf16_t*)(a.ws + OFF_QTO), (float*)(a.ws + OFF_BLO), (float*)(a.ws + OFF_TT), (float*)(a.ws + OFF_DGO), sq >> 2, sq & 3, g, (char*)lds_raw, opaque_s(wave) * 64 + opaque_lane()); }
                __syncthreads();
                if (!do_ab) {} else if (G >= 256) { if (bid < 128) moba::mixer_a_chunk((const bf16_t*)(a.ws + OFF_AV), (const bf16_t*)(a.ws + OFF_UZ), (bf16_t*)(a.ws + OFF_YA), (const bf16_t*)(a.ws + OFF_WA) + (size_t)l * 4 * 128 * 128, a.in[I_ALNG] + l * BW, a.in[I_ALNB] + l * BW, a.in[I_ASB] + l * 4 * 128, bid, (char*)lds_raw, opaque_s(wave) * 64 + opaque_lane()); else mixer_b_prep(a, l, bid - 128, lds, opaque_s(wave) * 64 + opaque_lane(), wave, opaque_lane()); }
                else { for (int c = bid; c < MH / 128; c += G) moba::mixer_a_chunk((const bf16_t*)(a.ws + OFF_AV), (const bf16_t*)(a.ws + OFF_UZ), (bf16_t*)(a.ws + OFF_YA), (const bf16_t*)(a.ws + OFF_WA) + (size_t)l * 4 * 128 * 128, a.in[I_ALNG] + l * BW, a.in[I_ALNB] + l * BW, a.in[I_ASB] + l * 4 * 128, c, (char*)lds_raw, opaque_s(wave) * 64 + opaque_lane()); for (int u = bid; u < BPH * 32; u += G) mixer_b_prep(a, l, u, lds, opaque_s(wave) * 64 + opaque_lane(), wave, opaque_lane()); }
                if (do_d) mixer_d_conv(a, l, opaque_s(wave) * 64 + opaque_lane());
            } else if (s == 3) {
                PHASE_ARGS; (void)tid; (void)lane;
                mixer_b_attn(a, (char*)lds_raw, wave, G, bid, l * NSPLIT + hf, l, OFF_CZ);
#if PROBE_REP == 13
            } else if (s == 13) {
                PHASE_ARGS; (void)lane; unsigned char* wl = a.ws + OFF_W + (size_t)l * W_LAYER_BYTES;
                SchedTiles S; S.so.init(MH, NCAT, G, bid); S.A = (const char*)(a.ws + OFF_H); S.B = (const char*)(wl + WOFF_CAT); S.tA = (size_t)256 * 1024 * 2; S.tB = (size_t)256 * 1024 * 2;
                EpiNull E;
                pg8::gemm_phase<EpiNull, SchedTiles, true>(lds, tid, 1024, 1024, 1024, S, E);
#endif
#if PROBE_REP == 12 || PROBE_REP == 14
            } else if (s == 12) {
                PHASE_ARGS; (void)tid; (void)lane;
                mixer_b_attn(a, (char*)lds_raw, wave, G, bid, 4 + l * NSPLIT + hf, l, OFF_DCX);
#endif
#if PROBE_REP == 10
            } else if (s == 10) {
                PHASE_ARGS; (void)wave; (void)lane;
                for (int u = bid; u < BPH * 4 * moba::NGRP; u += G) { const int sq = u / moba::NGRP, g = u % moba::NGRP;
                    moba::gla_local((const bf16_t*)(a.ws + OFF_CQK), (const bf16_t*)(a.ws + OFF_CV), (const float*)(a.ws + OFF_LRF), a.in[I_CW2] + (size_t)l * 16 * 256, a.in[I_CB] + (size_t)l * 256, (bf16_t*)(a.ws + OFF_OL), (bf16_t*)(a.ws + OFF_QTO), (float*)(a.ws + OFF_BLO), (float*)(a.ws + OFF_TT), (float*)(a.ws + OFF_DGO), sq >> 2, sq & 3, g, (char*)lds_raw, tid); }
#endif
#if PROBE_REP == 3
            } else if (s == 6) {
                PHASE_ARGS; (void)wave; (void)lane;
#endif
            } else if (s == 4) {
                PHASE_ARGS; (void)lane; unsigned char* wl = a.ws + OFF_W + (size_t)l * W_LAYER_BYTES;
                SchedP3 S; S.so.init(MH, 1024, G, bid); S.Y[0] = (const char*)(a.ws + OFF_YA); S.Y[1] = (const char*)(a.ws + OFF_YB); S.Y[2] = (const char*)(a.ws + OFF_CZ); S.Y[3] = (const char*)(a.ws + OFF_YD);
                S.Wbo = (const char*)(wl + WOFF_BO); S.tA = (size_t)256 * 512 * 2;
                EpiP3 E{(const bf16_t*)(a.ws + OFF_G), (bf16_t*)(a.ws + OFF_MERGED)};
                pg8::gemm_phase<EpiP3, SchedP3, true>(lds, tid, 512, 512, 512, S, E);
            } else {
                PHASE_ARGS; (void)lane; unsigned char* wl = a.ws + OFF_W + (size_t)l * W_LAYER_BYTES;
                SchedTiles S; S.so.init(MH, 1024, G, bid); S.A = (const char*)(a.ws + OFF_MERGED); S.B = (const char*)(wl + WOFF_OUT); S.tA = (size_t)256 * 1024 * 2; S.tB = (size_t)256 * 1024 * 2;
                EpiP4 E{(l == 0 ? a.in[I_X] : a.out) + (size_t)hf * MH * DM, a.out + (size_t)hf * MH * DM, lds + 131072};
                pg8::gemm_phase<EpiP4, SchedTiles, true>(lds, tid, 1024, 1024, 1024, S, E);
                if (MERGE_S0 && PROBE_REP != 0 && !(l == DEPTH - 1 && hf == NSPLIT - 1)) {
                    const int np = l * NSPLIT + hf + 1; __syncthreads();
                    phase_rmsnorm(a, np / NSPLIT, np % NSPLIT, lds, opaque_s(wave) * 64 + opaque_lane(), wave, opaque_lane()); }
            }
        }
        if (ph + 1 < ph_hi) { xcd_barrier(gbar); if (PROBE_REP == 20) { xcd_barrier(gbar); xcd_barrier(gbar); } }
        if (ph_hi < 0) cg::this_grid().sync();
    }
}

extern "C" void kernel_launch(void* const* d_in, const int* in_sizes, int n_in, void* d_out, int out_size, void* d_ws, size_t ws_size, hipStream_t stream) {
    static int grid = 0;
    if (grid == 0) {
        if (n_in != 18 || out_size != BATCH * SEQ * DM || ws_size < WS_END) { fprintf(stderr, "kernel_launch: unexpected shapes (n_in %d out %d ws %zu)\n", n_in, out_size, ws_size); grid = -1; return; }
        int dev = 0, cus = 0, per_cu = 0;
        (void)hipGetDevice(&dev); (void)hipDeviceGetAttribute(&cus, hipDeviceAttributeMultiprocessorCount, dev);
        (void)hipFuncSetAttribute((const void*)fwd_kernel, hipFuncAttributeMaxDynamicSharedMemorySize, LDS_BYTES);
        (void)hipOccupancyMaxActiveBlocksPerMultiprocessor(&per_cu, (const void*)fwd_kernel, NTHREADS, LDS_BYTES);
        if (per_cu < 1) { fprintf(stderr, "kernel_launch: occupancy query says %d blocks per CU\n", per_cu); per_cu = 1; }
        (void)hipGetLastError();
        grid = cus * 1;
    }
    if (grid < 0) return;
    Args a{};
    for (int i = 0; i < 18; ++i) a.in[i] = (const float*)d_in[i];
    a.out = (float*)d_out; a.ws = (unsigned char*)d_ws;
#if MK_N_LAUNCHES == 1
    (void)hipMemsetAsync((unsigned char*)d_ws + OFF_CTL, 0, CTL_BYTES, stream);
    a.ph_lo = 0; a.ph_hi = N_PHASES;
    void* args[] = {&a};
    hipError_t e = hipLaunchCooperativeKernel((const void*)fwd_kernel, dim3(grid), dim3(NTHREADS), args, LDS_BYTES, stream);
    if (e != hipSuccess) fprintf(stderr, "cooperative launch failed: %s (grid %d)\n", hipGetErrorString(e), grid);
#else
    for (int ph = 0; ph < N_PHASES; ++ph) {
        a.ph_lo = ph; a.ph_hi = ph + 1;
        hipLaunchKernelGGL(fwd_kernel, dim3(grid), dim3(NTHREADS), LDS_BYTES, stream, a);
    }
#endif
}
```
